# Optimizing an MI355X kernel written in HIP

```python
import math, functools
import jax, jax.numpy as jnp
from jax import lax
import numpy as np

D_MODEL = 1024
BATCH = 8
SEQ = 4096
DEPTH = 4

CTX_LEN = 256
GRID_W = 64

N_MOD = 9
D_FF = 2816
MACARON = 0.5
ALPHA = (2.0 * DEPTH) ** 0.25
BETA = (8.0 * DEPTH) ** -0.25
LN_EPS = 1e-5

S5_WIDTH = D_MODEL // 4
S5_GROUP = 16
S5_GROUPS = S5_WIDTH // S5_GROUP
S5_STATE = 64

RET_HEAD_DIM = 128
RET_WIDTH = D_MODEL - S5_WIDTH
RET_HEADS = RET_WIDTH // RET_HEAD_DIM
RET_CHUNK = 128
ROPE_BASE = 10000.0

GDN_WIDTH = D_MODEL // 2
GDN_HEAD_DIM = 128
GDN_HEADS = GDN_WIDTH // GDN_HEAD_DIM
GDN_CONV = 5
GDN_CHUNK = 64

RWKV_WIDTH = D_MODEL // 2
RWKV_HEAD_DIM = 64
RWKV_HEADS = RWKV_WIDTH // RWKV_HEAD_DIM
RWKV_DECAY_LORA = 32
RWKV_AAA_LORA = 32
RWKV_GATE_LORA = 96
RWKV_GN_EPS = 64e-5

AB_IN = S5_WIDTH + 4 * RET_WIDTH
AB_SPLIT = [S5_WIDTH, S5_WIDTH + RET_WIDTH, S5_WIDTH + 2 * RET_WIDTH, S5_WIDTH + 3 * RET_WIDTH]
GDN_IN = 4 * GDN_WIDTH + 4 * GDN_HEADS
GDN_SPLIT = [3 * GDN_WIDTH, 4 * GDN_WIDTH, 4 * GDN_WIDTH + 2 * GDN_HEADS]
RWKV_IN = 3 * RWKV_WIDTH + 2 * RWKV_DECAY_LORA + 2 * RWKV_AAA_LORA + RWKV_GATE_LORA
RWKV_SPLIT = [RWKV_WIDTH, 2 * RWKV_WIDTH, 3 * RWKV_WIDTH,
              3 * RWKV_WIDTH + 2 * RWKV_DECAY_LORA,
              3 * RWKV_WIDTH + 2 * RWKV_DECAY_LORA + 2 * RWKV_AAA_LORA]
CD_IN = GDN_IN + RWKV_IN
N_AB = (DEPTH + 1) // 2
N_CD = DEPTH // 2

kernel_name = "hybrid_s5_retnet_gdn_rwkv7_flow_trunk"


def layer_norm(x, g, b):
    xf = x.astype(jnp.float32)
    mu = jnp.mean(xf, -1, keepdims=True)
    var = jnp.mean(jnp.square(xf - mu), -1, keepdims=True)
    return ((xf - mu) * lax.rsqrt(var + LN_EPS) * g + b).astype(x.dtype)


def head_norm(x, eps):
    mu = jnp.mean(x, -1, keepdims=True)
    var = jnp.mean(jnp.square(x - mu), -1, keepdims=True)
    return (x - mu) * lax.rsqrt(var + eps)


def l2norm(x, eps=1e-6):
    return x * lax.rsqrt(jnp.sum(x * x, -1, keepdims=True) + eps)


def modulate(h, shift, scale):
    return h * (1.0 + scale) + shift


def swiglu(h, w_in, w_out):
    a, b = jnp.split(h @ w_in, 2, axis=-1)
    return (jax.nn.silu(a) * b) @ w_out


def post_norm(h, y, gate, g, b):
    return layer_norm(ALPHA * h + gate * y, g, b)


def ffn_half_step(h, shift, scale, gate, w_in, w_out, g, b):
    return post_norm(h, MACARON * swiglu(modulate(h, shift, scale), w_in, w_out), gate, g, b)


def centred_dwconv(x, w):
    k = w.shape[0]
    return lax.conv_general_dilated(x, w[:, None, :].astype(x.dtype), (1,), [(k // 2, k // 2)],
                                    dimension_numbers=("NWC", "WIO", "NWC"),
                                    feature_group_count=x.shape[-1])


def sym_shift(x):
    xp = jnp.pad(x, ((0, 0), (1, 1), (0, 0)))
    return 0.5 * (xp[:, :-2] + xp[:, 2:])


def axial_rope(x):
    n, d = x.shape[1], x.shape[-1]
    rows = n // GRID_W
    nf = d // 4
    freqs = ROPE_BASE ** (-jnp.arange(nf, dtype=jnp.float32) / nf)
    pr = jnp.broadcast_to(jnp.arange(rows, dtype=jnp.float32)[:, None], (rows, GRID_W)).reshape(-1)
    pc = jnp.broadcast_to(jnp.arange(GRID_W, dtype=jnp.float32)[None, :], (rows, GRID_W)).reshape(-1)
    ang = jnp.concatenate([pr[:, None] * freqs, pc[:, None] * freqs], -1)
    cos, sin = jnp.cos(ang)[None, :, None, :], jnp.sin(ang)[None, :, None, :]
    x1, x2 = jnp.split(x.astype(jnp.float32), 2, axis=-1)
    return jnp.concatenate([x1 * cos - x2 * sin, x1 * sin + x2 * cos], -1)


def bidirectional(scan_fns, ctx_dirs, lat_dirs, state0):
    y_ctx, y_lat = 0.0, 0.0
    for d in range(2):
        cs, ls = ctx_dirs[d], lat_dirs[d]
        if d == 1:
            cs = tuple(jnp.flip(t, 1) for t in cs)
            ls = tuple(jnp.flip(t, 1) for t in ls)
        yc, s_ctx = scan_fns[d](cs, state0)
        yl, _ = scan_fns[d](ls, s_ctx)
        if d == 1:
            yc, yl = jnp.flip(yc, 1), jnp.flip(yl, 1)
        y_ctx = y_ctx + yc
        y_lat = y_lat + yl
    return y_ctx, y_lat


def s5_discretise(lam_re, lam_im, log_dt, b_re, b_im):
    lam_re, lam_im = lam_re.astype(jnp.float32), lam_im.astype(jnp.float32)
    dt = jnp.exp(log_dt.astype(jnp.float32))[:, None]
    mag, ang = jnp.exp(lam_re * dt), lam_im * dt
    lb_re, lb_im = mag * jnp.cos(ang), mag * jnp.sin(ang)
    den = lam_re * lam_re + lam_im * lam_im
    nr = lb_re - 1.0
    coef_re = (nr * lam_re + lb_im * lam_im) / den
    coef_im = (lb_im * lam_re - nr * lam_im) / den
    b_re, b_im = b_re.astype(jnp.float32), b_im.astype(jnp.float32)
    bb_re = coef_re[..., None] * b_re - coef_im[..., None] * b_im
    bb_im = coef_re[..., None] * b_im + coef_im[..., None] * b_re
    return lb_re, lb_im, bb_re, bb_im


def complex_affine_combine(e1, e2):
    a1r, a1i, b1r, b1i = e1
    a2r, a2i, b2r, b2i = e2
    return (a1r * a2r - a1i * a2i, a1r * a2i + a1i * a2r,
            a2r * b1r - a2i * b1i + b2r, a2r * b1i + a2i * b1r + b2i)


def s5_scan(seq, state0, lam_bar_re, lam_bar_im, c_re, c_im):
    bu_re, bu_im = seq
    n = bu_re.shape[1]
    a_re = jnp.broadcast_to(lam_bar_re, (1, n) + lam_bar_re.shape)
    a_im = jnp.broadcast_to(lam_bar_im, (1, n) + lam_bar_im.shape)
    acc_re, acc_im, h_re, h_im = lax.associative_scan(
        complex_affine_combine, (a_re, a_im, bu_re, bu_im), axis=1)
    h0_re, h0_im = state0[0][:, None], state0[1][:, None]
    h_re, h_im = (h_re + acc_re * h0_re - acc_im * h0_im,
                  h_im + acc_re * h0_im + acc_im * h0_re)
    y = (jnp.einsum("blgp,gcp->blgc", h_re, c_re)
         - jnp.einsum("blgp,gcp->blgc", h_im, c_im))
    return y, (h_re[:, -1], h_im[:, -1])


def s5_drive(gu, bb_re, bb_im):
    return (jnp.einsum("blgc,gpc->blgp", gu, bb_re), jnp.einsum("blgc,gpc->blgp", gu, bb_im))


def s5_branch(u_c, u_l, lam_re, lam_im, log_dt, b_re, b_im, c_re, c_im, d_skip, glu_w, glu_b):
    def groups(u):
        return u.astype(jnp.float32).reshape(u.shape[0], u.shape[1], S5_GROUPS, S5_GROUP)
    gu_c, gu_l = groups(u_c), groups(u_l)
    c_re, c_im = c_re.astype(jnp.float32), c_im.astype(jnp.float32)
    scan_fns, ctx_dirs, lat_dirs = [], [], []
    for d in range(2):
        lb_re, lb_im, bb_re, bb_im = s5_discretise(lam_re[d], lam_im[d], log_dt[d], b_re, b_im)
        scan_fns.append(functools.partial(s5_scan, lam_bar_re=lb_re, lam_bar_im=lb_im,
                                          c_re=c_re, c_im=c_im))
        ctx_dirs.append(s5_drive(gu_c, bb_re, bb_im))
        lat_dirs.append(s5_drive(gu_l, bb_re, bb_im))
    zeros = jnp.zeros((u_c.shape[0], S5_GROUPS, S5_STATE), jnp.float32)
    y_c, y_l = bidirectional(scan_fns, ctx_dirs, lat_dirs, (zeros, zeros))

    def finish(y, gu):
        y = (y + d_skip.reshape(S5_GROUPS, S5_GROUP) * gu).reshape(gu.shape[0], gu.shape[1], S5_WIDTH)
        z = jax.nn.gelu(y)
        return z * jax.nn.sigmoid(z @ glu_w + glu_b)
    return finish(y_c, gu_c), finish(y_l, gu_l)


def chunk_retention(seq, state0, log_gamma):
    q, k, v = seq
    b, n, h, _ = q.shape
    cs = RET_CHUNK
    nc = n // cs
    q, k, v = (t.reshape(b, nc, cs, h, -1) for t in (q, k, v))
    idx = jnp.arange(cs, dtype=jnp.float32)
    diff = idx[:, None] - idx[None, :]
    past = diff >= 0
    decay = jnp.where(past, jnp.exp(jnp.where(past, diff, 0.0)[None] * log_gamma[:, None, None]), 0.0)
    scores = jnp.einsum("bnihd,bnjhd->bnhij", q, k) * decay
    intra = jnp.einsum("bnhij,bnjhe->bnihe", scores, v)
    zeta = jnp.exp((cs - 1.0 - idx)[:, None] * log_gamma)
    kv = jnp.einsum("bnjhd,jh,bnjhe->nbhde", k, zeta, v)
    chunk_decay = jnp.exp(cs * log_gamma)[:, None, None]

    def step(s, kv_n):
        return chunk_decay * s + kv_n, s
    s_final, s_prev = lax.scan(step, state0, kv)
    xi = jnp.exp((idx + 1.0)[:, None] * log_gamma)
    inter = jnp.einsum("bnihd,ih,nbhde->bnihe", q, xi, s_prev)
    return (intra + inter).reshape(b, n, h, -1), s_final


def retention_branch(p_c, p_l, log_rate):
    scale = RET_HEAD_DIM ** -0.5

    def heads(t):
        return t.astype(jnp.float32).reshape(t.shape[0], t.shape[1], RET_HEADS, RET_HEAD_DIM)
    q_c, k_c, v_c, g_c = p_c
    q_l, k_l, v_l, g_l = p_l
    seq_c = (heads(q_c), heads(k_c) * scale, heads(v_c))
    seq_l = (axial_rope(heads(q_l)), axial_rope(heads(k_l)) * scale, heads(v_l))
    log_gamma = -jnp.exp(log_rate.astype(jnp.float32))
    scan_fns = [functools.partial(chunk_retention, log_gamma=log_gamma[d]) for d in range(2)]
    state0 = jnp.zeros((q_c.shape[0], RET_HEADS, RET_HEAD_DIM, RET_HEAD_DIM), jnp.float32)
    o_c, o_l = bidirectional(scan_fns, (seq_c, seq_c), (seq_l, seq_l), state0)

    def finish(o, g):
        return jax.nn.silu(g.astype(jnp.float32)) * head_norm(o, LN_EPS).reshape(g.shape)
    return finish(o_c, g_c), finish(o_l, g_l)


def s5_retention_mixer(h_c, h_l, w_in, w_out, lam_re, lam_im, log_dt, b_re, b_im, c_re, c_im,
                       d_skip, glu_w, glu_b, ret_log_rate):
    u_c, q_c, k_c, v_c, g_c = jnp.split(h_c @ w_in, AB_SPLIT, axis=-1)
    u_l, q_l, k_l, v_l, g_l = jnp.split(h_l @ w_in, AB_SPLIT, axis=-1)
    a_c, a_l = s5_branch(u_c, u_l, lam_re, lam_im, log_dt, b_re, b_im, c_re, c_im, d_skip, glu_w, glu_b)
    r_c, r_l = retention_branch((q_c, k_c, v_c, g_c), (q_l, k_l, v_l, g_l), ret_log_rate)
    y_c = jnp.concatenate([a_c, r_c], -1).astype(h_c.dtype) @ w_out
    y_l = jnp.concatenate([a_l, r_l], -1).astype(h_l.dtype) @ w_out
    return y_c, y_l


def to_blocks(t, chunk):
    b, n = t.shape[:2]
    return jnp.moveaxis(t.reshape((b, n // chunk, chunk) + t.shape[2:]), 3, 2)


def chunk_gated_delta(seq, state0):
    q, k, v, g, beta = seq
    b, n, h, _ = q.shape
    cs = GDN_CHUNK
    q, k, v, g, beta = (to_blocks(t, cs) for t in (q, k, v, g, beta))
    gcum = jnp.cumsum(g, axis=-1)
    idx = jnp.arange(cs)
    incl = idx[:, None] >= idx[None, :]
    strict = idx[:, None] > idx[None, :]
    decay = jnp.where(incl, jnp.exp(jnp.where(incl, gcum[..., :, None] - gcum[..., None, :], 0.0)), 0.0)
    kb = k * beta[..., None]
    a_mat = jnp.where(strict, jnp.einsum("bnhid,bnhjd->bnhij", kb, k) * decay, 0.0)
    eye = jnp.eye(cs, dtype=jnp.float32)
    t_mat = lax.linalg.triangular_solve(a_mat + eye, jnp.broadcast_to(eye, a_mat.shape),
                                        left_side=True, lower=True, unit_diagonal=True)
    w = t_mat @ (kb * jnp.exp(gcum)[..., None])
    u = t_mat @ (v * beta[..., None])
    attn = jnp.einsum("bnhid,bnhjd->bnhij", q, k) * decay
    q_dec = q * jnp.exp(gcum)[..., None]
    k_dec = k * jnp.exp(gcum[..., -1:] - gcum)[..., None]
    g_last = jnp.exp(gcum[..., -1])[..., None, None]

    def step(s, blk):
        w_n, u_n, attn_n, qd_n, kd_n, gl_n = blk
        v_new = u_n - w_n @ s
        o_n = qd_n @ s + attn_n @ v_new
        s = s * gl_n + jnp.swapaxes(kd_n, -1, -2) @ v_new
        return s, o_n
    s_final, o = lax.scan(step, state0,
                          tuple(jnp.moveaxis(t, 1, 0) for t in (w, u, attn, q_dec, k_dec, g_last)))
    o = jnp.moveaxis(jnp.moveaxis(o, 0, 1), 3, 2)
    return o.reshape(b, n, h, -1), s_final


def deltanet_branch(p_c, p_l, conv_w, a_log, dt_bias, norm_w):
    a_log, dt_bias = a_log.astype(jnp.float32), dt_bias.astype(jnp.float32)

    def prep(p):
        bsz, n = p.shape[:2]
        qkv, z, a_in, b_in = jnp.split(p, GDN_SPLIT, axis=-1)
        qkv = jax.nn.silu(centred_dwconv(qkv, conv_w).astype(jnp.float32))
        q, k, v = (t.reshape(bsz, n, GDN_HEADS, GDN_HEAD_DIM) for t in jnp.split(qkv, 3, axis=-1))
        q = l2norm(q) * GDN_HEAD_DIM ** -0.5
        k = l2norm(k)
        a_in = a_in.astype(jnp.float32).reshape(bsz, n, 2, GDN_HEADS)
        beta = jax.nn.sigmoid(b_in.astype(jnp.float32)).reshape(bsz, n, 2, GDN_HEADS)
        g = -jnp.exp(a_log) * jax.nn.softplus(a_in + dt_bias)
        return [(q, k, v, g[:, :, d], beta[:, :, d]) for d in range(2)], z
    dirs_c, z_c = prep(p_c)
    dirs_l, z_l = prep(p_l)
    state0 = jnp.zeros((p_c.shape[0], GDN_HEADS, GDN_HEAD_DIM, GDN_HEAD_DIM), jnp.float32)
    o_c, o_l = bidirectional((chunk_gated_delta, chunk_gated_delta), dirs_c, dirs_l, state0)

    def finish(o, z):
        o = o * lax.rsqrt(jnp.mean(o * o, -1, keepdims=True) + 1e-6) * norm_w
        return o.reshape(z.shape) * jax.nn.silu(z.astype(jnp.float32))
    return finish(o_c, z_c), finish(o_l, z_l)


def rwkv7_scan(seq, state0):
    seq_t = tuple(jnp.moveaxis(t, 1, 0) for t in seq)

    def step(s, inp):
        r, w, k, v, a, bb = inp
        sa = jnp.einsum("bhvk,bhk->bhv", s, a)
        s = s * w[:, :, None, :] + sa[..., None] * bb[:, :, None, :] + v[..., None] * k[:, :, None, :]
        return s, jnp.einsum("bhvk,bhk->bhv", s, r)
    s_final, y = lax.scan(step, state0, seq_t)
    return jnp.moveaxis(y, 0, 1), s_final


def rwkv7_branch(p_c, p_l, mu, w0, w_up, a0, a_up, g_up, k_k, k_a, r_k, ln_w, ln_b):
    def prep(p):
        bsz, n = p.shape[:2]
        p = p.astype(jnp.float32)
        p = p + mu * (sym_shift(p) - p)
        r, k, v, wd, ad, gd = jnp.split(p, RWKV_SPLIT, axis=-1)

        def hd(t):
            return t.reshape(bsz, n, RWKV_HEADS, RWKV_HEAD_DIM)
        kk = l2norm(hd(k * k_k))
        g = jax.nn.sigmoid(gd) @ g_up
        wd = wd.reshape(bsz, n, 2, RWKV_DECAY_LORA)
        ad = ad.reshape(bsz, n, 2, RWKV_AAA_LORA)
        dirs = []
        for d in range(2):
            w_log = -jax.nn.softplus(-(w0[d] + jnp.tanh(wd[:, :, d]) @ w_up[d])) - 0.5
            a = jax.nn.sigmoid(a0[d] + ad[:, :, d] @ a_up[d])
            k_d = k * (1.0 + (a - 1.0) * k_a)
            dirs.append((hd(r), hd(jnp.exp(-jnp.exp(w_log))), hd(k_d), hd(v), -kk, kk * hd(a)))
        return dirs, g
    dirs_c, g_c = prep(p_c)
    dirs_l, g_l = prep(p_l)
    state0 = jnp.zeros((p_c.shape[0], RWKV_HEADS, RWKV_HEAD_DIM, RWKV_HEAD_DIM), jnp.float32)
    y_c, y_l = bidirectional((rwkv7_scan, rwkv7_scan), dirs_c, dirs_l, state0)

    def finish(y, dirs, g):
        bsz, n = y.shape[:2]
        y = head_norm(y, RWKV_GN_EPS).reshape(bsz, n, RWKV_WIDTH) * ln_w + ln_b
        r, v = dirs[0][0], dirs[0][3]
        bonus = (jnp.sum(r * dirs[0][2] * r_k, -1, keepdims=True)
                 + jnp.sum(r * dirs[1][2] * r_k, -1, keepdims=True)) * v
        return (y + bonus.reshape(bsz, n, RWKV_WIDTH)) * g
    return finish(y_c, dirs_c, g_c), finish(y_l, dirs_l, g_l)


def deltanet_rwkv_mixer(h_c, h_l, w_in, w_out, conv_w, a_log, dt_bias, norm_w, mu, w0, w_up,
                        a0, a_up, g_up, k_k, k_a, r_k, ln_w, ln_b):
    p_c, p_l = h_c @ w_in, h_l @ w_in
    d_c, d_l = deltanet_branch(p_c[..., :GDN_IN], p_l[..., :GDN_IN], conv_w, a_log, dt_bias, norm_w)
    r_c, r_l = rwkv7_branch(p_c[..., GDN_IN:], p_l[..., GDN_IN:], mu, w0, w_up, a0, a_up, g_up,
                            k_k, k_a, r_k, ln_w, ln_b)
    y_c = jnp.concatenate([d_c, r_c], -1).astype(h_c.dtype) @ w_out
    y_l = jnp.concatenate([d_l, r_l], -1).astype(h_l.dtype) @ w_out
    return y_c, y_l


def setup_inputs(seed: int = 0) -> dict:
    key = jax.random.key(seed)
    ks = jax.random.split(key, 48)
    f32 = jnp.float32

    def nrm(i, shape, std):
        return std * jax.random.normal(ks[i], shape, f32)

    def unif(i, shape, lo, hi):
        return jax.random.uniform(ks[i], shape, f32, lo, hi)
    D, G, P, W = D_MODEL, S5_GROUPS, S5_STATE, RWKV_WIDTH
    ret_base = jnp.log(-jnp.log(1.0 - 2.0 ** (-5.0 - jnp.arange(RET_HEADS, dtype=f32))))
    gdn_dt = jnp.exp(unif(27, (N_CD, 2, GDN_HEADS), math.log(1e-3), math.log(1e-1)))
    w0_base = -6.0 + 5.0 * jnp.linspace(0.0, 1.0, W, dtype=f32) ** 1.35
    return {
        "x": nrm(0, (BATCH, SEQ, D), 1.0),
        "c": nrm(1, (BATCH, D), 1.0),
        "ctx": nrm(2, (BATCH, CTX_LEN, D), 1.0),
        "c_ctx": nrm(3, (D,), 1.0),
        "ada_w": nrm(4, (DEPTH, D, N_MOD * D), D ** -0.5),
        "ada_b": nrm(5, (DEPTH, N_MOD * D), 0.02),
        "ffn_w_in": nrm(6, (DEPTH, 2, D, 2 * D_FF), D ** -0.5),
        "ffn_w_out": nrm(7, (DEPTH, 2, D_FF, D), BETA * D_FF ** -0.5),
        "ln_g": 1.0 + nrm(8, (DEPTH, 3, D), 0.02),
        "ln_b": nrm(9, (DEPTH, 3, D), 0.02),
        "ab_w_in": nrm(10, (N_AB, D, AB_IN), D ** -0.5),
        "ab_w_out": nrm(11, (N_AB, S5_WIDTH + RET_WIDTH, D), BETA * D ** -0.5),
        "s5_lam_re": -0.5 + nrm(12, (N_AB, 2, G, P), 0.01),
        "s5_lam_im": math.pi * jnp.arange(P, dtype=f32) + nrm(13, (N_AB, 2, G, P), 0.01),
        "s5_log_dt": unif(14, (N_AB, 2, G), math.log(1e-3), math.log(1e-1)),
        "s5_b_re": nrm(15, (N_AB, G, P, S5_GROUP), S5_GROUP ** -0.5),
        "s5_b_im": nrm(16, (N_AB, G, P, S5_GROUP), S5_GROUP ** -0.5),
        "s5_c_re": nrm(17, (N_AB, G, S5_GROUP, P), P ** -0.5),
        "s5_c_im": nrm(18, (N_AB, G, S5_GROUP, P), P ** -0.5),
        "s5_d": nrm(19, (N_AB, S5_WIDTH), 1.0),
        "s5_glu_w": nrm(20, (N_AB, S5_WIDTH, S5_WIDTH), S5_WIDTH ** -0.5),
        "s5_glu_b": nrm(21, (N_AB, S5_WIDTH), 0.02),
        "ret_log_rate": ret_base + nrm(22, (N_AB, 2, RET_HEADS), 0.05),
        "cd_w_in": nrm(23, (N_CD, D, CD_IN), D ** -0.5),
        "cd_w_out": nrm(24, (N_CD, GDN_WIDTH + RWKV_WIDTH, D), BETA * D ** -0.5),
        "gdn_conv_w": nrm(25, (N_CD, GDN_CONV, 3 * GDN_WIDTH), GDN_CONV ** -0.5),
        "gdn_a_log": jnp.log(unif(26, (N_CD, 2, GDN_HEADS), 1.0, 16.0)),
        "gdn_dt_bias": gdn_dt + jnp.log(-jnp.expm1(-gdn_dt)),
        "gdn_norm_w": 1.0 + nrm(28, (N_CD, GDN_HEAD_DIM), 0.02),
        "rwkv_mu": unif(29, (N_CD, RWKV_IN), 0.0, 1.0),
        "rwkv_w0": w0_base + nrm(30, (N_CD, 2, W), 0.1),
        "rwkv_w_up": nrm(31, (N_CD, 2, RWKV_DECAY_LORA, W), 0.1 * RWKV_DECAY_LORA ** -0.5),
        "rwkv_a0": nrm(32, (N_CD, 2, W), 0.1),
        "rwkv_a_up": nrm(33, (N_CD, 2, RWKV_AAA_LORA, W), RWKV_AAA_LORA ** -0.5),
        "rwkv_g_up": nrm(34, (N_CD, RWKV_GATE_LORA, W), RWKV_GATE_LORA ** -0.5),
        "rwkv_k_k": 0.85 + nrm(35, (N_CD, W), 0.02),
        "rwkv_k_a": 1.0 + nrm(36, (N_CD, W), 0.02),
        "rwkv_r_k": nrm(37, (N_CD, RWKV_HEADS, RWKV_HEAD_DIM), 0.1),
        "rwkv_ln_w": 1.0 + nrm(38, (N_CD, W), 0.02),
        "rwkv_ln_b": nrm(39, (N_CD, W), 0.02),
    }


def reference(x, c, ctx, c_ctx, ada_w, ada_b, ffn_w_in, ffn_w_out, ln_g, ln_b,
              ab_w_in, ab_w_out, s5_lam_re, s5_lam_im, s5_log_dt, s5_b_re, s5_b_im, s5_c_re, s5_c_im,
              s5_d, s5_glu_w, s5_glu_b, ret_log_rate,
              cd_w_in, cd_w_out, gdn_conv_w, gdn_a_log, gdn_dt_bias, gdn_norm_w,
              rwkv_mu, rwkv_w0, rwkv_w_up, rwkv_a0, rwkv_a_up, rwkv_g_up, rwkv_k_k, rwkv_k_a, rwkv_r_k,
              rwkv_ln_w, rwkv_ln_b):
    h_lat, h_ctx = x, ctx
    s_lat, s_ctx = jax.nn.silu(c), jax.nn.silu(c_ctx)
    for i in range(DEPTH):
        m_lat = (s_lat @ ada_w[i] + ada_b[i]).reshape(-1, N_MOD, 1, D_MODEL)
        m_ctx = (s_ctx @ ada_w[i] + ada_b[i]).reshape(1, N_MOD, 1, D_MODEL)
        ml = [m_lat[:, j] for j in range(N_MOD)]
        mc = [m_ctx[:, j] for j in range(N_MOD)]

        h_lat = ffn_half_step(h_lat, ml[0], ml[1], ml[2], ffn_w_in[i, 0], ffn_w_out[i, 0], ln_g[i, 0], ln_b[i, 0])
        h_ctx = ffn_half_step(h_ctx, mc[0], mc[1], mc[2], ffn_w_in[i, 0], ffn_w_out[i, 0], ln_g[i, 0], ln_b[i, 0])

        x_lat = modulate(h_lat, ml[3], ml[4])
        x_ctx = modulate(h_ctx, mc[3], mc[4])
        j = i // 2
        if i % 2 == 0:
            y_ctx, y_lat = s5_retention_mixer(
                x_ctx, x_lat, ab_w_in[j], ab_w_out[j], s5_lam_re[j], s5_lam_im[j], s5_log_dt[j],
                s5_b_re[j], s5_b_im[j], s5_c_re[j], s5_c_im[j], s5_d[j], s5_glu_w[j], s5_glu_b[j],
                ret_log_rate[j])
        else:
            y_ctx, y_lat = deltanet_rwkv_mixer(
                x_ctx, x_lat, cd_w_in[j], cd_w_out[j], gdn_conv_w[j], gdn_a_log[j], gdn_dt_bias[j],
                gdn_norm_w[j], rwkv_mu[j], rwkv_w0[j], rwkv_w_up[j], rwkv_a0[j], rwkv_a_up[j],
                rwkv_g_up[j], rwkv_k_k[j], rwkv_k_a[j], rwkv_r_k[j], rwkv_ln_w[j], rwkv_ln_b[j])
        h_lat = post_norm(h_lat, y_lat, ml[5], ln_g[i, 1], ln_b[i, 1])

        h_lat = ffn_half_step(h_lat, ml[6], ml[7], ml[8], ffn_w_in[i, 1], ffn_w_out[i, 1], ln_g[i, 2], ln_b[i, 2])
        if i < DEPTH - 1:
            h_ctx = post_norm(h_ctx, y_ctx, mc[5], ln_g[i, 1], ln_b[i, 1])
            h_ctx = ffn_half_step(h_ctx, mc[6], mc[7], mc[8], ffn_w_in[i, 1], ffn_w_out[i, 1], ln_g[i, 2], ln_b[i, 2])
    return h_lat
```

```cpp
#include <hip/hip_runtime.h>
#include <hip/hip_bf16.h>
#include <hip/hip_cooperative_groups.h>
#include <cstdio>
namespace cg = cooperative_groups;

typedef unsigned short u16;
using bf16x8 = __attribute__((ext_vector_type(8))) short;
using f32x4 = __attribute__((ext_vector_type(4))) float;

#ifndef PROBE_MASK
#define PROBE_MASK 0
#endif
constexpr int NT = 512;
constexpr int LDS_BYTES = 155648;
constexpr int MLAT = 32768, MCTX = 2048, MROWS = 34816, DM = 1024, DFF = 2816;
constexpr int AB_NP = 3328, CD_NP = 3840, CD_IN_V = 3824;
constexpr float ALPHA = 1.681792830507429f;

enum { I_X = 0, I_C, I_CTX, I_CCTX, I_ADAW, I_ADAB, I_FFI, I_FFO, I_LNG, I_LNB, I_ABWI, I_ABWO, I_LAMRE, I_LAMIM,
       I_LOGDT, I_BRE, I_BIM, I_CRE, I_CIM, I_S5D, I_GLUW, I_GLUB, I_RETLR, I_CDWI, I_CDWO, I_CONVW, I_ALOG,
       I_DTB, I_GNW, I_MU, I_W0, I_WUP, I_A0, I_AUP, I_GUP, I_KK, I_KA, I_RK, I_LNW, I_LNBB };

constexpr size_t WB_SLOT = 50331648;
constexpr size_t OFF_HCTX = 2 * WB_SLOT;
constexpr size_t OFF_XMOD = OFF_HCTX + 8388608;
constexpr size_t OFF_R = OFF_XMOD + 71303168;
constexpr size_t OFF_OUTDIR = OFF_R + 267386880;
constexpr size_t OFF_ZBUF = OFF_OUTDIR + 142606336;
constexpr size_t OFF_MODS = OFF_ZBUF + 17825792;
constexpr size_t OFF_ROPE = OFF_MODS + 1327104;
constexpr size_t OFF_S5TAB = OFF_ROPE + 16384;
constexpr size_t OFF_BONUS = OFF_S5TAB + 557056;
constexpr size_t OFF_BAR = OFF_BONUS + 2228224;
constexpr size_t OFF_PART = OFF_BAR + 16384;
constexpr size_t OFF_RSTAT = OFF_PART + 16777216;
constexpr size_t WS_END = OFF_RSTAT + 262144;
constexpr size_t WFI0 = 0, WFI1 = 5767168, WFO0 = 11534336, WFO1 = 14417920, WMI = 17301504, WMO = 21233664, WGLU = 22282240;

struct Params {
  const float* in[40];
  float* out;
  char* ws;
};


__device__ __forceinline__ long zoff() { int z = 0; asm volatile("" : "+s"(z)); return (long)z; }
__device__ __forceinline__ const float* inp(const Params& P, int i) { return P.in[i] + zoff(); }
__device__ __forceinline__ char* wsp(const Params& P) { return P.ws + zoff(); }
__device__ __forceinline__ float* outp(const Params& P) { return P.out + zoff(); }
__device__ __forceinline__ int TID() { int t = threadIdx.x; asm volatile("" : "+v"(t)); return t; }
__device__ __forceinline__ int BID() { int b = blockIdx.x; asm volatile("" : "+s"(b)); return b; }

__device__ __forceinline__ float bf2f(u16 u) { return __uint_as_float(((unsigned)u) << 16); }
typedef __bf16 bf16x2_hw __attribute__((ext_vector_type(2)));
typedef float f32x2_hw __attribute__((ext_vector_type(2)));
__device__ __forceinline__ u16 f2bf(float f) { return __builtin_bit_cast(u16, (__bf16)f); }
__device__ __forceinline__ unsigned pack2(float a, float b) {
  f32x2_hw v = {a, b};
  return __builtin_bit_cast(unsigned, __builtin_convertvector(v, bf16x2_hw));
}
__device__ __forceinline__ float lo16(unsigned u) { return __uint_as_float(u << 16); }
__device__ __forceinline__ float hi16(unsigned u) { return __uint_as_float(u & 0xffff0000u); }
__device__ __forceinline__ float sigmoidf_(float x) { return __builtin_amdgcn_rcpf(1.0f + __expf(-x)); }
__device__ __forceinline__ float siluf_(float x) { return x * __builtin_amdgcn_rcpf(1.0f + __expf(-x)); }
__device__ __forceinline__ float softplusf_(float x) { return fmaxf(x, 0.0f) + log1pf(__expf(-fabsf(x))); }
__device__ __forceinline__ float geluf_(float x) {
  float u = 0.7978845608028654f * (x + 0.044715f * x * x * x);
  return x * __builtin_amdgcn_rcpf(1.0f + __expf(-2.0f * u));
}
template <int CTRL>
__device__ __forceinline__ float dpp_add(float x) {
  int v = __builtin_amdgcn_update_dpp(0, __float_as_int(x), CTRL, 0xf, 0xf, true);
  return x + __int_as_float(v);
}
__device__ __forceinline__ float reduce16(float x) {
  x = dpp_add<0xB1>(x);
  x = dpp_add<0x4E>(x);
  x = dpp_add<0x141>(x);
  x = dpp_add<0x140>(x);
  return x;
}
__device__ __forceinline__ float reduce8(float x) {
  x = dpp_add<0xB1>(x);
  x = dpp_add<0x4E>(x);
  x = dpp_add<0x141>(x);
  return x;
}
__device__ __forceinline__ float wave_sum(float x) {
  x = reduce16(x);
  const int xi = __float_as_int(x);
  return (__int_as_float(__builtin_amdgcn_readlane(xi, 0)) + __int_as_float(__builtin_amdgcn_readlane(xi, 16))) +
         (__int_as_float(__builtin_amdgcn_readlane(xi, 32)) + __int_as_float(__builtin_amdgcn_readlane(xi, 48)));
}
__device__ __forceinline__ float* hrow(const Params& P, int row) {
  return row < MLAT ? outp(P) + (size_t)row * DM : (float*)(wsp(P) + OFF_HCTX) + (size_t)(row - MLAT) * DM;
}

__device__ __forceinline__ void mods_phase(const Params& P) {
  extern __shared__ __attribute__((aligned(16))) char smem[];
  float* s = (float*)smem;
  float* red = s + 9 * 1024;
  const int tid = TID();
  for (int i = tid; i < 9 * 1024; i += NT) {
    int who = i >> 10, k = i & 1023;
    float v = who < 8 ? inp(P, I_C)[who * 1024 + k] : inp(P, I_CCTX)[k];
    s[i] = v / (1.0f + expf(-v));
  }
  __syncthreads();
  float* mods = (float*)(wsp(P) + OFF_MODS);
  const float* adaw = inp(P, I_ADAW);
  const float* adab = inp(P, I_ADAB);
  for (int item = BID(); item < 576; item += gridDim.x) {
    int l = item / 144, n0 = (item % 144) * 64;
    int n4 = tid & 15, ks = tid >> 4;
    float acc[9][4];
#pragma unroll
    for (int w = 0; w < 9; ++w) { acc[w][0] = 0.f; acc[w][1] = 0.f; acc[w][2] = 0.f; acc[w][3] = 0.f; }
    const float* wp = adaw + ((size_t)l * 1024 + ks * 32) * 9216 + n0 + n4 * 4;
#pragma unroll 4
    for (int kk = 0; kk < 32; ++kk) {
      float4 w = *(const float4*)(wp + (size_t)kk * 9216);
      int k = ks * 32 + kk;
#pragma unroll
      for (int who = 0; who < 9; ++who) {
        float sv = s[who * 1024 + k];
        acc[who][0] += sv * w.x; acc[who][1] += sv * w.y; acc[who][2] += sv * w.z; acc[who][3] += sv * w.w;
      }
    }
#pragma unroll
    for (int who = 0; who < 9; ++who) {
      float4 v; v.x = acc[who][0]; v.y = acc[who][1]; v.z = acc[who][2]; v.w = acc[who][3];
      *(float4*)(red + (ks * 9 + who) * 64 + n4 * 4) = v;
    }
    __syncthreads();
    for (int o = tid; o < 576; o += NT) {
      int who = o >> 6, n = o & 63;
      float sum = adab[l * 9216 + n0 + n];
      for (int q = 0; q < 32; ++q) sum += red[(q * 9 + who) * 64 + n];
      mods[(size_t)(l * 9 + who) * 9216 + n0 + n] = sum;
    }
    __syncthreads();
  }
}

__device__ __forceinline__ void tables_phase(const Params& P) {
  const int gt = BID() * NT + TID(), gs = gridDim.x * NT;
  float* rope = (float*)(wsp(P) + OFF_ROPE);
  for (int i = gt; i < 2048; i += gs) {
    int pos = i >> 5, f = i & 31;
    float freq = powf(10000.0f, -(float)f / 32.0f);
    float ang = (float)pos * freq;
    rope[i * 2] = cosf(ang);
    rope[i * 2 + 1] = sinf(ang);
  }
  float* tab = (float*)(wsp(P) + OFF_S5TAB);
  for (int i = gt; i < 4096; i += gs) {
    int p = i & 63, g = (i >> 6) & 15, jd = i >> 10;
    int j = jd >> 1;
    float lre = inp(P, I_LAMRE)[(jd * 16 + g) * 64 + p];
    float lim = inp(P, I_LAMIM)[(jd * 16 + g) * 64 + p];
    float dt = expf(inp(P, I_LOGDT)[jd * 16 + g]);
    float mag = expf(lre * dt), ang = lim * dt;
    float lbr = mag * cosf(ang), lbi = mag * sinf(ang);
    float den = lre * lre + lim * lim;
    float nr = lbr - 1.0f;
    float cre = (nr * lre + lbi * lim) / den;
    float cim = (lbi * lre - nr * lim) / den;
    float* t = tab + (size_t)jd * 34816;
    t[g * 64 + p] = lbr;
    t[1024 + g * 64 + p] = lbi;
    const float* bre = inp(P, I_BRE) + ((size_t)(j * 16 + g) * 64 + p) * 16;
    const float* bim = inp(P, I_BIM) + ((size_t)(j * 16 + g) * 64 + p) * 16;
    for (int c = 0; c < 16; ++c) {
      float br = bre[c], bi = bim[c];
      t[2048 + (g * 64 + p) * 16 + c] = cre * br - cim * bi;
      t[2048 + 16384 + (g * 64 + p) * 16 + c] = cre * bi + cim * br;
    }
  }
}

__device__ __forceinline__ void conv_mat(const float* __restrict__ src, int K, int Nsrc, int Npad, bool perm, u16* __restrict__ dst, int rot) {
  extern __shared__ __attribute__((aligned(16))) char smem[];
  float* tile = (float*)smem;
  const int tid = TID();
  const int nk = K / 64, ntiles = nk * (Npad / 64);
  int start = (BID() + gridDim.x - (rot % gridDim.x)) % gridDim.x;
  for (int t = start; t < ntiles; t += gridDim.x) {
    int kt = t % nk, ntile = t / nk;
    int k0 = kt * 64, n0 = ntile * 64;
    {
      int r = tid >> 6, c = tid & 63;
      int np = n0 + c;
      int col = np;
      if (perm) { int blk = np >> 5, w = np & 31; int jj = blk * 16 + (w & 15); col = (w < 16) ? jj : DFF + jj; }
      bool ok = np < Nsrc;
#pragma unroll
      for (int i = 0; i < 8; ++i) {
        int k = k0 + r + 8 * i;
        tile[(r + 8 * i) * 65 + c] = ok ? src[(size_t)k * Nsrc + col] : 0.0f;
      }
    }
    __syncthreads();
    {
      int nn = tid >> 3, kg = tid & 7;
      uint4 o;
      o.x = pack2(tile[(kg * 8 + 0) * 65 + nn], tile[(kg * 8 + 1) * 65 + nn]);
      o.y = pack2(tile[(kg * 8 + 2) * 65 + nn], tile[(kg * 8 + 3) * 65 + nn]);
      o.z = pack2(tile[(kg * 8 + 4) * 65 + nn], tile[(kg * 8 + 5) * 65 + nn]);
      o.w = pack2(tile[(kg * 8 + 6) * 65 + nn], tile[(kg * 8 + 7) * 65 + nn]);
      *(uint4*)(dst + (size_t)(n0 + nn) * K + k0 + kg * 8) = o;
    }
    __syncthreads();
  }
}

__device__ __forceinline__ void convert_layer(const Params& P, int l) {
  u16* wb = (u16*)(wsp(P) + (size_t)(l & 1) * WB_SLOT);
  const int j = l >> 1;
  const bool ab = (l & 1) == 0;
  for (int m = 0; m < 7; ++m) {
    const float* src; int K, Nsrc, Npad, rot; bool perm = false; u16* dst;
    if (m < 2) { src = inp(P, I_FFI) + (size_t)(l * 2 + m) * 1024 * 5632; K = 1024; Nsrc = 5632; Npad = 5632; perm = true; dst = wb + (m ? WFI1 : WFI0); rot = m * 128; }
    else if (m < 4) { src = inp(P, I_FFO) + (size_t)(l * 2 + (m - 2)) * 2816 * 1024; K = 2816; Nsrc = 1024; Npad = 1024; dst = wb + (m == 3 ? WFO1 : WFO0); rot = (m - 2) * 192; }
    else if (m == 4) {
      if (ab) { src = inp(P, I_ABWI) + (size_t)j * 1024 * AB_NP; Nsrc = AB_NP; Npad = AB_NP; }
      else { src = inp(P, I_CDWI) + (size_t)j * 1024 * CD_IN_V; Nsrc = CD_IN_V; Npad = CD_NP; }
      K = 1024; dst = wb + WMI; rot = 128;
    }
    else if (m == 5) { src = (ab ? inp(P, I_ABWO) : inp(P, I_CDWO)) + (size_t)j * 1024 * 1024; K = 1024; Nsrc = 1024; Npad = 1024; dst = wb + WMO; rot = 64; }
    else { if (!ab) continue; src = inp(P, I_GLUW) + (size_t)j * 65536; K = 256; Nsrc = 256; Npad = 256; dst = wb + WGLU; rot = 32; }
    conv_mat(src, K, Nsrc, Npad, perm, dst, rot);
  }
}

__device__ __forceinline__ void rowpass(const Params& P, bool init, const float* lng, const float* lnb, const float* modsNext, int js, int jc, int nrows, bool parts) {
  const int tid_ = TID(); const int lane = tid_ & 63, wave = tid_ >> 6;
  u16* xmod = (u16*)(wsp(P) + OFF_XMOD);
  const int stride = gridDim.x * 8;
  float4 g4[4], b4[4];
#pragma unroll
  for (int i = 0; i < 4; ++i) { g4[i] = make_float4(1.f, 1.f, 1.f, 1.f); b4[i] = make_float4(0.f, 0.f, 0.f, 0.f); }
  if (!init) {
#pragma unroll
    for (int i = 0; i < 4; ++i) { g4[i] = *(const float4*)(lng + i * 256 + lane * 4); b4[i] = *(const float4*)(lnb + i * 256 + lane * 4); }
  }
  auto srcrow = [&](int row) -> const float* {
    return init ? (row < MLAT ? inp(P, I_X) + (size_t)row * DM : inp(P, I_CTX) + (size_t)(row - MLAT) * DM) : hrow(P, row);
  };
  int row = BID() * 8 + wave;
  float4 v[4], vn[4];
  if (row < nrows) {
    const float* src = srcrow(row);
#pragma unroll
    for (int i = 0; i < 4; ++i) v[i] = *(const float4*)(src + i * 256 + lane * 4);
  }
  while (row < nrows) {
    const int nrow = row + stride;
    if (nrow < nrows) {
      const float* src = srcrow(nrow);
#pragma unroll
      for (int i = 0; i < 4; ++i) vn[i] = *(const float4*)(src + i * 256 + lane * 4);
    }
    const int who = row < MLAT ? (row >> 12) : 8;
    float4 sa[4], sc4[4];
    if (modsNext) {
      const float* sh = modsNext + (size_t)who * 9216 + js * 1024;
      const float* sc = modsNext + (size_t)who * 9216 + jc * 1024;
#pragma unroll
      for (int i = 0; i < 4; ++i) { sa[i] = *(const float4*)(sh + i * 256 + lane * 4); sc4[i] = *(const float4*)(sc + i * 256 + lane * 4); }
    }
    float* dst = hrow(P, row);
    if (parts && row >= MLAT) {
      const float* p0 = (const float*)(wsp(P) + OFF_PART) + (size_t)(row - MLAT) * DM;
      const float* p1 = p0 + (size_t)MCTX * DM;
#pragma unroll
      for (int i = 0; i < 4; ++i) {
        const float4 a = *(const float4*)(p0 + i * 256 + lane * 4), c = *(const float4*)(p1 + i * 256 + lane * 4);
        v[i].x = ALPHA * v[i].x + (a.x + c.x); v[i].y = ALPHA * v[i].y + (a.y + c.y);
        v[i].z = ALPHA * v[i].z + (a.z + c.z); v[i].w = ALPHA * v[i].w + (a.w + c.w);
      }
    }
    if (!init) {
      float s = 0.f;
#pragma unroll
      for (int i = 0; i < 4; ++i) s += v[i].x + v[i].y + v[i].z + v[i].w;
      s = wave_sum(s);
      float mu = s * (1.0f / 1024.0f);
      float q = 0.f;
#pragma unroll
      for (int i = 0; i < 4; ++i) {
        float a = v[i].x - mu, b = v[i].y - mu, c = v[i].z - mu, d = v[i].w - mu;
        q += a * a + b * b + c * c + d * d;
      }
      q = wave_sum(q);
      float rstd = rsqrtf(q * (1.0f / 1024.0f) + 1e-5f);
      if (row < MLAT && lane == 0) *(float2*)((float*)(wsp(P) + OFF_RSTAT) + (size_t)row * 2) = make_float2(mu, rstd);
#pragma unroll
      for (int i = 0; i < 4; ++i) {
        v[i].x = (v[i].x - mu) * rstd * g4[i].x + b4[i].x;
        v[i].y = (v[i].y - mu) * rstd * g4[i].y + b4[i].y;
        v[i].z = (v[i].z - mu) * rstd * g4[i].z + b4[i].z;
        v[i].w = (v[i].w - mu) * rstd * g4[i].w + b4[i].w;
      }
    }
    if (row >= MLAT || !modsNext) {
#pragma unroll
      for (int i = 0; i < 4; ++i) *(float4*)(dst + i * 256 + lane * 4) = v[i];
    }
    if (modsNext) {
#pragma unroll
      for (int i = 0; i < 4; ++i) {
        uint2 o;
        o.x = pack2(v[i].x * (1.0f + sc4[i].x) + sa[i].x, v[i].y * (1.0f + sc4[i].y) + sa[i].y);
        o.y = pack2(v[i].z * (1.0f + sc4[i].z) + sa[i].z, v[i].w * (1.0f + sc4[i].w) + sa[i].w);
        *(uint2*)(xmod + (size_t)row * DM + i * 256 + lane * 4) = o;
      }
    }
#pragma unroll
    for (int i = 0; i < 4; ++i) v[i] = vn[i];
    row = nrow;
  }
}

constexpr int GBK = 64, GHALF = 128, GHT = GHALF * GBK;
__device__ __forceinline__ int lds_byte(int r, int c) {
  int st = (r >> 4) * 2 + (c >> 5), rr = r & 15, cc = c & 31, ob = rr * 64 + cc * 2;
  return st * 1024 + (ob ^ (((ob >> 9) & 1) << 5));
}
__device__ __forceinline__ void stage_rc(int b, int& R, int& C) {
  int st = b / 1024, sb = b % 1024, swz = sb ^ (((sb >> 9) & 1) << 5);
  R = (st >> 1) * 16 + swz / 64; C = (st & 1) * 32 + (swz % 64) / 2;
}
enum { EPI_ACT = 0, EPI_RES = 1, EPI_PBF = 2, EPI_GLU = 3 };
struct EpiArgs {
  u16* outbf; int ld;
  const float* gate; float sc;
  const u16* zbuf; const float* glub;
  int nm;
  int split;
  const float* plng; const float* plnb;
  const float* hsrc;
};

template <int MODE>
__device__ __forceinline__ void gemm_phase(const Params& P, const u16* __restrict__ A, const u16* __restrict__ Bt, int N, int K, EpiArgs e) {
  extern __shared__ __attribute__((aligned(16))) char smem[];
  u16* shm = (u16*)smem;
#define SA(b, h) (shm + ((b) * 4 + (h)) * GHT)
#define SB(b, h) (shm + ((b) * 4 + 2 + (h)) * GHT)
#define STAGE(Pp, BASE, br, kt) do { unsigned long long _g = (unsigned long long)(BASE + (long)(br) * K + (long)(kt) * GBK); \
    unsigned _lo = __builtin_amdgcn_readfirstlane((unsigned)_g), _hi = __builtin_amdgcn_readfirstlane((unsigned)(_g >> 32)); \
    const char* _sp = (const char*)(((unsigned long long)_hi << 32) | _lo); \
    __builtin_amdgcn_global_load_lds((const unsigned*)(_sp + so0), (__attribute__((address_space(3))) unsigned*)((char*)(Pp) + lo0s), 16, 0, 0); \
    __builtin_amdgcn_global_load_lds((const unsigned*)(_sp + (size_t)128 * K + so0), (__attribute__((address_space(3))) unsigned*)((char*)(Pp) + lo0s + 8192), 16, 0, 0); } while (0)
#define LDA(dst, b, h) _Pragma("unroll") for (int m = 0; m < 4; ++m) _Pragma("unroll") for (int k = 0; k < 2; ++k) \
    dst[m][k] = *reinterpret_cast<const bf16x8*>((char*)SA(b, h) + a_off + m * 2048 + k * 1024)
#define LDB(dst, b, h) _Pragma("unroll") for (int n = 0; n < 2; ++n) _Pragma("unroll") for (int k = 0; k < 2; ++k) \
    dst[n][k] = *reinterpret_cast<const bf16x8*>((char*)SB(b, h) + b_off + n * 2048 + k * 1024)
#define MMA(ai, bj, At_, Bt_) do { __builtin_amdgcn_s_setprio(1); \
    _Pragma("unroll") for (int m = 0; m < 4; ++m) _Pragma("unroll") for (int n = 0; n < 2; ++n) _Pragma("unroll") for (int k = 0; k < 2; ++k) \
      acc[ai][bj][m][n] = __builtin_amdgcn_mfma_f32_16x16x32_bf16(At_[m][k], Bt_[n][k], acc[ai][bj][m][n], 0, 0, 0); \
    __builtin_amdgcn_s_setprio(0); } while (0)
#define WAIT_V(n) asm volatile("s_waitcnt vmcnt(" #n ")" ::: "memory")
#define WAIT_L(n) asm volatile("s_waitcnt lgkmcnt(" #n ")" ::: "memory")
#define BAR __builtin_amdgcn_s_barrier()
#define SCHED __builtin_amdgcn_sched_barrier(0)
  const int nN = N / 256, nM = e.nm ? e.nm : MROWS / 256, ntiles = nM * nN;
  const int nwork = ntiles + (e.split ? 2 * 8 * nN : 0);
  const int tid = TID();
  const int wid = __builtin_amdgcn_readfirstlane(tid >> 6);
  const int lane = tid & 63, wr = wid >> 2, wc = wid & 3, fr = lane & 15, fq = lane >> 4;
  const int lo0s = wid * 1024;
  unsigned so0;
  { int r, c; stage_rc(tid * 16, r, c); so0 = (unsigned)(r * K + c) * 2u; }
  const int a_off = lds_byte(wr * 64 + fr, fq * 8), b_off = lds_byte(wc * 32 + fr, fq * 8);
  const int bid = BID();
  const int nb = gridDim.x;
  const int slot = (nb % 8 == 0) ? (bid % 8) * (nb / 8) + bid / 8 : bid;
  auto decode = [&](int W, bool& part, int& ksel, int& nt, int& brow, int& bcol, const u16*& A_, const u16*& Bt_) {
    part = W >= ntiles;
    const int T = part ? ntiles + ((W - ntiles) >> 1) : W;
    ksel = part ? ((W - ntiles) & 1) : 0;
    nt = part ? K / (2 * GBK) : K / GBK;
    const int nMt = part ? nM + 8 : nM;
    const int nig = 8 * nN, gid = T / nig, fm = gid * 8, gsz = min(nMt - fm, 8);
    const int pm = fm + ((T % nig) % gsz), pn = (T % nig) / gsz;
    brow = pm * 256; bcol = pn * 256;
    A_ = A + (part ? ksel * (K / 2) : 0);
    Bt_ = Bt + (part ? ksel * (K / 2) : 0);
  };
  constexpr int EPI_OFF = 86016;
  if (slot < nwork) {
    bool part; int ksel, nt, brow, bcol; const u16* A_; const u16* Bt_;
    decode(slot, part, ksel, nt, brow, bcol, A_, Bt_);
    STAGE(SB(0, 0), Bt_, bcol, 0); STAGE(SA(0, 0), A_, brow, 0);
    STAGE(SB(0, 1), Bt_, bcol + GHALF, 0); STAGE(SA(0, 1), A_, brow + GHALF, 0);
  }
  for (int W = slot; W < nwork; W += nb) {
    bool part; int ksel, nt, brow, bcol; const u16* A_; const u16* Bt_;
    decode(W, part, ksel, nt, brow, bcol, A_, Bt_);
    f32x4 acc[2][2][4][2];
#pragma unroll
    for (int a = 0; a < 2; ++a)
#pragma unroll
      for (int b = 0; b < 2; ++b)
#pragma unroll
        for (int m = 0; m < 4; ++m)
#pragma unroll
          for (int n = 0; n < 2; ++n) acc[a][b][m][n] = (f32x4){0.f, 0.f, 0.f, 0.f};
    bf16x8 At[4][2], B0[2][2], B1[2][2];
    if (wr == 1) BAR;
    WAIT_V(4); BAR;
    STAGE(SB(1, 0), Bt_, bcol, 1); STAGE(SA(1, 0), A_, brow, 1); STAGE(SB(1, 1), Bt_, bcol + GHALF, 1);
    WAIT_V(6); BAR;
    for (int t = 0; t < nt - 2; t += 2) {
      LDB(B0, 0, 0); SCHED; LDA(At, 0, 0); STAGE(SA(1, 1), A_, brow + GHALF, t + 1);
      WAIT_L(8); BAR; WAIT_L(0); MMA(0, 0, At, B0); BAR; SCHED;
      LDB(B1, 0, 1); STAGE(SB(0, 0), Bt_, bcol, t + 2);
      BAR; WAIT_L(0); MMA(0, 1, At, B1); BAR;
      LDA(At, 0, 1); STAGE(SA(0, 0), A_, brow, t + 2);
      BAR; WAIT_L(0); MMA(1, 0, At, B0); BAR; SCHED;
      STAGE(SB(0, 1), Bt_, bcol + GHALF, t + 2);
      WAIT_V(6); BAR; MMA(1, 1, At, B1); BAR;
      LDB(B0, 1, 0); SCHED; LDA(At, 1, 0); STAGE(SA(0, 1), A_, brow + GHALF, t + 2);
      WAIT_L(8); BAR; WAIT_L(0); MMA(0, 0, At, B0); BAR; SCHED;
      LDB(B1, 1, 1); STAGE(SB(1, 0), Bt_, bcol, t + 3);
      BAR; WAIT_L(0); MMA(0, 1, At, B1); BAR;
      LDA(At, 1, 1); STAGE(SA(1, 0), A_, brow, t + 3);
      BAR; WAIT_L(0); MMA(1, 0, At, B0); BAR; SCHED;
      STAGE(SB(1, 1), Bt_, bcol + GHALF, t + 3);
      WAIT_V(6); BAR; MMA(1, 1, At, B1); BAR;
    }
    { LDB(B0, 0, 0); LDA(At, 0, 0); STAGE(SA(1, 1), A_, brow + GHALF, nt - 1);
      BAR; WAIT_L(0); MMA(0, 0, At, B0); BAR;
      LDB(B1, 0, 1); BAR; WAIT_L(0); MMA(0, 1, At, B1); BAR;
      LDA(At, 0, 1); WAIT_V(4); BAR; WAIT_L(0); MMA(1, 0, At, B0); MMA(1, 1, At, B1); BAR; }
    { LDB(B0, 1, 0); LDA(At, 1, 0); WAIT_V(2); BAR; WAIT_L(0); MMA(0, 0, At, B0); BAR;
      LDB(B1, 1, 1); WAIT_V(0); BAR; WAIT_L(0); MMA(0, 1, At, B1); BAR;
      LDA(At, 1, 1); BAR; WAIT_L(0); MMA(1, 0, At, B0); MMA(1, 1, At, B1); BAR; }
    if (wr == 0) BAR;
    const int who = brow < MLAT ? (brow >> 12) : 8;
    const int lane_e = TID() & 63;
    int fr_e = lane_e & 15, fq_e = lane_e >> 4;
    asm volatile("" : "+v"(fr_e), "+v"(fq_e));
    auto prefetch_next = [&]() {
      if (W + nb < nwork) {
        bool part2; int ksel2, nt2, brow2, bcol2; const u16* A2; const u16* Bt2;
        decode(W + nb, part2, ksel2, nt2, brow2, bcol2, A2, Bt2);
        STAGE(SB(0, 0), Bt2, bcol2, 0); STAGE(SA(0, 0), A2, brow2, 0);
        STAGE(SB(0, 1), Bt2, bcol2 + GHALF, 0); STAGE(SA(0, 1), A2, brow2 + GHALF, 0);
      }
    };
    if (MODE == EPI_RES) {
      constexpr int LDW = 260;
      float* st = (float*)(smem + EPI_OFF);
      int tq = TID();
      const int c4 = (tq & 63) * 4, r0 = tq >> 6;
      float4 g4 = *(const float4*)(e.gate + (size_t)who * 9216 + bcol + c4);
      g4.x *= e.sc; g4.y *= e.sc; g4.z *= e.sc; g4.w *= e.sc;
      float4 lg4 = make_float4(1.f, 1.f, 1.f, 1.f), lb4 = make_float4(0.f, 0.f, 0.f, 0.f);
      if (e.plng) { lg4 = *(const float4*)(e.plng + bcol + c4); lb4 = *(const float4*)(e.plnb + bcol + c4); }
#pragma unroll
      for (int ai = 0; ai < 2; ++ai) {
#pragma unroll
        for (int wq = 0; wq < 2; ++wq) {
          if (wr == wq) {
#pragma unroll
            for (int bj = 0; bj < 2; ++bj)
#pragma unroll
              for (int m = 0; m < 4; ++m)
#pragma unroll
                for (int n = 0; n < 2; ++n)
#pragma unroll
                  for (int jj = 0; jj < 4; ++jj)
                    st[(m * 16 + fq_e * 4 + jj) * LDW + bj * GHALF + wc * 32 + n * 16 + fr_e] = acc[ai][bj][m][n][jj];
          }
          if (ai == 1 && wq == 1) prefetch_next();
          WAIT_L(0); BAR;
          if (part) {
#pragma unroll 4
            for (int it = 0; it < 8; ++it) {
              const int rl = it * 8 + r0;
              const float4 v = *(const float4*)(st + rl * LDW + c4);
              const int grow = brow + ai * GHALF + wq * 64 + rl;
              float* pp = (float*)(wsp(P) + OFF_PART) + ((size_t)ksel * MCTX + (grow - MLAT)) * DM + bcol + c4;
              *(float4*)pp = make_float4(g4.x * v.x, g4.y * v.y, g4.z * v.z, g4.w * v.w);
            }
          } else {
#pragma unroll
            for (int gq = 0; gq < 2; ++gq) {
              float4 hq[4]; float2 msq[4];
#pragma unroll
              for (int i4 = 0; i4 < 4; ++i4) {
                const int grow = brow + ai * GHALF + wq * 64 + (gq * 4 + i4) * 8 + r0;
                if (e.plng) {
                  hq[i4] = *(const float4*)(hrow(P, grow) + bcol + c4);
                  msq[i4] = *(const float2*)((const float*)(wsp(P) + OFF_RSTAT) + (size_t)grow * 2);
                } else {
                  hq[i4] = *(const float4*)(e.hsrc + (size_t)grow * DM + bcol + c4);
                  msq[i4] = make_float2(0.f, 1.f);
                }
              }
#pragma unroll
              for (int i4 = 0; i4 < 4; ++i4) {
                const int rl = (gq * 4 + i4) * 8 + r0;
                const float4 v = *(const float4*)(st + rl * LDW + c4);
                const int grow = brow + ai * GHALF + wq * 64 + rl;
                float4 h4 = hq[i4];
                if (e.plng) {
                  const float2 ms = msq[i4];
                  h4.x = (h4.x - ms.x) * ms.y * lg4.x + lb4.x; h4.y = (h4.y - ms.x) * ms.y * lg4.y + lb4.y;
                  h4.z = (h4.z - ms.x) * ms.y * lg4.z + lb4.z; h4.w = (h4.w - ms.x) * ms.y * lg4.w + lb4.w;
                }
                h4.x = ALPHA * h4.x + g4.x * v.x; h4.y = ALPHA * h4.y + g4.y * v.y;
                h4.z = ALPHA * h4.z + g4.z * v.z; h4.w = ALPHA * h4.w + g4.w * v.w;
                *(float4*)(hrow(P, grow) + bcol + c4) = h4;
              }
            }
          }
          WAIT_L(0); BAR;
        }
      }
    } else if (MODE == EPI_ACT) {
      constexpr int LDH = 136;
      u16* st = (u16*)(smem + EPI_OFF);
#pragma unroll
      for (int ai = 0; ai < 2; ++ai)
#pragma unroll
        for (int bj = 0; bj < 2; ++bj)
#pragma unroll
          for (int m = 0; m < 4; ++m)
#pragma unroll
            for (int jj = 0; jj < 4; ++jj) {
              float av = acc[ai][bj][m][0][jj], bv = acc[ai][bj][m][1][jj];
              st[(ai * GHALF + wr * 64 + m * 16 + fq_e * 4 + jj) * LDH + bj * 64 + wc * 16 + fr_e] = f2bf(siluf_(av) * bv);
            }
      prefetch_next();
      WAIT_L(0); BAR;
      int tq = TID();
      const int pc = (tq & 15) * 8, r0 = tq >> 4;
#pragma unroll 4
      for (int it = 0; it < 8; ++it) {
        const int rl = it * 32 + r0;
        *(uint4*)(e.outbf + (size_t)(brow + rl) * e.ld + (bcol >> 1) + pc) = *(const uint4*)(st + rl * LDH + pc);
      }
      WAIT_L(0); BAR;
    } else if (MODE == EPI_PBF) {
      constexpr int LDH = 264;
      u16* st = (u16*)(smem + EPI_OFF);
      int tq = TID();
      const int pc = (tq & 31) * 8, r0 = tq >> 5;
#pragma unroll
      for (int ai = 0; ai < 2; ++ai) {
#pragma unroll
        for (int bj = 0; bj < 2; ++bj)
#pragma unroll
          for (int m = 0; m < 4; ++m)
#pragma unroll
            for (int n = 0; n < 2; ++n)
#pragma unroll
              for (int jj = 0; jj < 4; ++jj)
                st[(wr * 64 + m * 16 + fq_e * 4 + jj) * LDH + bj * GHALF + wc * 32 + n * 16 + fr_e] = f2bf(acc[ai][bj][m][n][jj]);
        if (ai == 1) prefetch_next();
        WAIT_L(0); BAR;
#pragma unroll 4
        for (int it = 0; it < 8; ++it) {
          const int rl = it * 16 + r0;
          *(uint4*)(e.outbf + (size_t)(brow + ai * GHALF + rl) * e.ld + bcol + pc) = *(const uint4*)(st + rl * LDH + pc);
        }
        WAIT_L(0); BAR;
      }
    } else {
#pragma unroll
      for (int ai = 0; ai < 2; ++ai)
#pragma unroll
        for (int bj = 0; bj < 2; ++bj)
#pragma unroll
          for (int m = 0; m < 4; ++m)
#pragma unroll
            for (int jj = 0; jj < 4; ++jj) {
              const int row = brow + ai * GHALF + wr * 64 + m * 16 + fq_e * 4 + jj;
#pragma unroll
              for (int n = 0; n < 2; ++n) {
                const int col = bcol + bj * GHALF + wc * 32 + n * 16 + fr_e;
                float v = acc[ai][bj][m][n][jj];
                float z = bf2f(e.zbuf[(size_t)row * 256 + col]);
                e.outbf[(size_t)row * e.ld + col] = f2bf(z * sigmoidf_(v + e.glub[col]));
              }
            }
      prefetch_next();
    }
    WAIT_V(0);
    BAR;
  }
#undef SA
#undef SB
#undef STAGE
#undef LDA
#undef LDB
#undef MMA
}

__device__ __forceinline__ void chunk_map(int ci, int dir, int b, int& t0, int& L, int& rowbase, bool& isctx) {
  isctx = ci < 4;
  int cc = isctx ? ci : ci - 4;
  int nch = isctx ? 4 : 64;
  int cn = dir ? nch - 1 - cc : cc;
  t0 = cn * 64;
  L = isctx ? 256 : 4096;
  rowbase = isctx ? MLAT + b * 256 : b * 4096;
}

__device__ __forceinline__ void ld8(const u16* p, float* o) {
  uint4 u = *(const uint4*)p;
  o[0] = lo16(u.x); o[1] = hi16(u.x); o[2] = lo16(u.y); o[3] = hi16(u.y);
  o[4] = lo16(u.z); o[5] = hi16(u.z); o[6] = lo16(u.w); o[7] = hi16(u.w);
}
__device__ __forceinline__ void ld4(const u16* p, float* o) {
  uint2 u = *(const uint2*)p;
  o[0] = lo16(u.x); o[1] = hi16(u.x); o[2] = lo16(u.y); o[3] = hi16(u.y);
}

typedef float v2f __attribute__((ext_vector_type(2)));
__device__ __forceinline__ void unpack8(uint4 u, float* o) {
  o[0] = lo16(u.x); o[1] = hi16(u.x); o[2] = lo16(u.y); o[3] = hi16(u.y);
  o[4] = lo16(u.z); o[5] = hi16(u.z); o[6] = lo16(u.w); o[7] = hi16(u.w);
}
__device__ __forceinline__ uint4 ldz4(const u16* p, bool ok) {
  uint4 v = *(const uint4*)p;
  v.x = ok ? v.x : 0u; v.y = ok ? v.y : 0u; v.z = ok ? v.z : 0u; v.w = ok ? v.w : 0u;
  return v;
}
__device__ __forceinline__ uint2 ldz2(const u16* p, bool ok) {
  uint2 v = *(const uint2*)p;
  v.x = ok ? v.x : 0u; v.y = ok ? v.y : 0u;
  return v;
}
template <int MODE>
__device__ __forceinline__ void colscan_item(const Params& P, int item, int j) {
  extern __shared__ __attribute__((aligned(16))) char smem[];
  float* sCW = (float*)smem;
  float* sSc = sCW + 1600;
  float* sV = sSc + 256;
  float* sO = sV + 4096;
  float* sK = sO + 4096;
  float* sQ = sK + 8192;
  u16* sRaw = (u16*)(sQ + 8192);
  const int tid = TID(), lane = tid & 63, wid = tid >> 6;
  const int half = item & 1, chain = item >> 1, dir = chain & 1, hb = chain >> 1;
  constexpr int H = MODE == 0 ? 4 : 6;
  constexpr int NP = MODE == 0 ? CD_NP : AB_NP;
  const int h = hb % H, b = hb / H;
  const int qc = MODE == 0 ? h * 128 : 256 + h * 128;
  const int kc = MODE == 0 ? 512 + h * 128 : 1024 + h * 128;
  const int vc = (MODE == 0 ? 1024 : 1792) + h * 128 + half * 64;
  const int ocol = (MODE == 0 ? 0 : 256) + h * 128 + half * 64;
  const u16* p = (const u16*)(wsp(P) + OFF_R);
  u16* od = (u16*)(wsp(P) + OFF_OUTDIR) + (size_t)dir * MROWS * DM;
  const float* rope = (const float*)(wsp(P) + OFF_ROPE);
  float c_a = 0.f, c_b = 0.f;
  if (MODE == 0) {
    c_a = -expf(inp(P, I_ALOG)[(j * 2 + dir) * 4 + h]);
    c_b = inp(P, I_DTB)[(j * 2 + dir) * 4 + h];
    const float* cw = inp(P, I_CONVW) + (size_t)j * 5 * 1536;
    for (int i = tid; i < 1600; i += NT) {
      float v;
      if (i < 640) { int tap = i >> 7, c = i & 127; v = cw[tap * 1536 + h * 128 + c]; }
      else if (i < 1280) { int q = i - 640; int tap = q >> 7, c = q & 127; v = cw[tap * 1536 + 512 + h * 128 + c]; }
      else { int q = i - 1280; int tap = q >> 6, c = q & 63; v = cw[tap * 1536 + 1024 + h * 128 + half * 64 + c]; }
      sCW[i] = v;
    }
  } else {
    c_a = expf(-expf(inp(P, I_RETLR)[(j * 2 + dir) * 6 + h]));
  }
  v2f S0[8], S1[8];
#pragma unroll
  for (int i = 0; i < 8; ++i) { S0[i] = (v2f){0.f, 0.f}; S1[i] = (v2f){0.f, 0.f}; }
  const int l8 = lane & 7, col = (wid & 3) * 16 + (lane >> 3) * 2;
  const int t = tid >> 3, part = tid & 7;
  uint4 rq0, rq1, rk0, rk1, rv;
  auto prefetch = [&](int ci) {
    int t0, L, rowbase; bool isctx;
    chunk_map(ci, dir, b, t0, L, rowbase, isctx);
    const u16* pr = p + ((size_t)rowbase + t0 + t) * NP;
    rq0 = *(const uint4*)(pr + qc + part * 8);
    rq1 = *(const uint4*)(pr + qc + 64 + part * 8);
    rk0 = *(const uint4*)(pr + kc + part * 8);
    rk1 = *(const uint4*)(pr + kc + 64 + part * 8);
    rv = *(const uint4*)(pr + vc + part * 8);
  };
  rq0 = rq1 = rk0 = rk1 = rv = make_uint4(0, 0, 0, 0);
  if (MODE != 0) prefetch(0);
  __syncthreads();
  const int t_c = tid >> 3, part_c = tid & 7;
  for (int ci = 0; ci < 68; ++ci) {
    int t0, L, rowbase; bool isctx;
    chunk_map(ci, dir, b, t0, L, rowbase, isctx);
    int t = t_c, part = part_c;
    asm volatile("" : "+v"(t), "+v"(part));

    {
      const int tt = t0 + t;
      if (MODE == 0) {
        unsigned rab_;
        {
          const u16* pr = p + ((size_t)rowbase + tt) * NP;
          uint4 a0 = *(const uint4*)(pr + qc + part * 16), a1 = *(const uint4*)(pr + qc + part * 16 + 8);
          uint4 b0 = *(const uint4*)(pr + kc + part * 16), b1 = *(const uint4*)(pr + kc + part * 16 + 8);
          uint4 c0 = *(const uint4*)(pr + vc + part * 8);
          rab_ = (unsigned)pr[2048 + dir * 4 + h] | ((unsigned)pr[2056 + dir * 4 + h] << 16);
          u16* rr = sRaw + (t + 2) * 320;
          *(uint4*)(rr + part * 16) = a0; *(uint4*)(rr + part * 16 + 8) = a1;
          *(uint4*)(rr + 128 + part * 16) = b0; *(uint4*)(rr + 128 + part * 16 + 8) = b1;
          *(uint4*)(rr + 256 + part * 8) = c0;
          if (t < 4) {
            const int ts = t < 2 ? t0 - 2 + t : t0 + 62 + t;
            const bool ok = ts >= 0 && ts < L;
            const u16* ph = p + ((size_t)rowbase + (ok ? ts : tt)) * NP;
            u16* hh = sRaw + (t < 2 ? t : 64 + t) * 320;
            *(uint4*)(hh + part * 16) = ldz4(ph + qc + part * 16, ok); *(uint4*)(hh + part * 16 + 8) = ldz4(ph + qc + part * 16 + 8, ok);
            *(uint4*)(hh + 128 + part * 16) = ldz4(ph + kc + part * 16, ok); *(uint4*)(hh + 128 + part * 16 + 8) = ldz4(ph + kc + part * 16 + 8, ok);
            *(uint4*)(hh + 256 + part * 8) = ldz4(ph + vc + part * 8, ok);
          }
        }
        __syncthreads();
        float q[16], k[16], v[8];
#pragma unroll
        for (int i = 0; i < 16; ++i) { q[i] = 0.f; k[i] = 0.f; }
#pragma unroll
        for (int i = 0; i < 8; ++i) v[i] = 0.f;
#pragma unroll
        for (int tap = 0; tap < 5; ++tap) {
          const u16* rr = sRaw + (t + tap) * 320;
          float x[16];
          unpack8(*(const uint4*)(rr + part * 16), x); unpack8(*(const uint4*)(rr + part * 16 + 8), x + 8);
#pragma unroll
          for (int i = 0; i < 16; ++i) q[i] += x[i] * sCW[tap * 128 + part * 16 + i];
          unpack8(*(const uint4*)(rr + 128 + part * 16), x); unpack8(*(const uint4*)(rr + 128 + part * 16 + 8), x + 8);
#pragma unroll
          for (int i = 0; i < 16; ++i) k[i] += x[i] * sCW[640 + tap * 128 + part * 16 + i];
          unpack8(*(const uint4*)(rr + 256 + part * 8), x);
#pragma unroll
          for (int i = 0; i < 8; ++i) v[i] += x[i] * sCW[1280 + tap * 64 + part * 8 + i];
        }
        float sq = 0.f, sk = 0.f;
#pragma unroll
        for (int i = 0; i < 16; ++i) { q[i] = siluf_(q[i]); k[i] = siluf_(k[i]); sq += q[i] * q[i]; sk += k[i] * k[i]; }
        sq = reduce8(sq); sk = reduce8(sk);
        float rq = rsqrtf(sq + 1e-6f) * 0.08838834764831845f, rk = rsqrtf(sk + 1e-6f);
        float qk = 0.f;
#pragma unroll
        for (int i = 0; i < 16; ++i) { q[i] *= rq; k[i] *= rk; qk += q[i] * k[i]; }
        qk = reduce8(qk);
#pragma unroll
        for (int i = 0; i < 16; i += 4) {
          *(float4*)(sQ + t * 128 + part * 16 + i) = make_float4(q[i], q[i + 1], q[i + 2], q[i + 3]);
          *(float4*)(sK + t * 128 + part * 16 + i) = make_float4(k[i], k[i + 1], k[i + 2], k[i + 3]);
        }
        *(float4*)(sV + t * 64 + part * 8) = make_float4(siluf_(v[0]), siluf_(v[1]), siluf_(v[2]), siluf_(v[3]));
        *(float4*)(sV + t * 64 + part * 8 + 4) = make_float4(siluf_(v[4]), siluf_(v[5]), siluf_(v[6]), siluf_(v[7]));
        if (part == 0) {
          float ain = lo16(rab_), bin = hi16(rab_);
          *(float4*)(sSc + t * 4) = make_float4(__expf(c_a * softplusf_(ain + c_b)), sigmoidf_(bin), qk, 0.f);
        }
      } else {
        float q1[8], q2[8], k1[8], k2[8], v[8];
        unpack8(rq0, q1); unpack8(rq1, q2); unpack8(rk0, k1); unpack8(rk1, k2); unpack8(rv, v);
        if (!isctx) {
          int pos = part < 4 ? (tt >> 6) : (tt & 63);
          int f0 = (part & 3) * 8;
#pragma unroll
          for (int i = 0; i < 8; ++i) {
            float2 cs = *(const float2*)(rope + (pos * 32 + f0 + i) * 2);
            float a = q1[i], bb = q2[i];
            q1[i] = a * cs.x - bb * cs.y; q2[i] = a * cs.y + bb * cs.x;
            a = k1[i]; bb = k2[i];
            k1[i] = a * cs.x - bb * cs.y; k2[i] = a * cs.y + bb * cs.x;
          }
        }
        float qk = 0.f;
#pragma unroll
        for (int i = 0; i < 8; ++i) {
          k1[i] *= 0.08838834764831845f; k2[i] *= 0.08838834764831845f;
          qk += q1[i] * k1[i] + q2[i] * k2[i];
        }
        qk = reduce8(qk);
#pragma unroll
        for (int i = 0; i < 8; i += 4) {
          *(float4*)(sQ + t * 128 + part * 8 + i) = make_float4(q1[i], q1[i + 1], q1[i + 2], q1[i + 3]);
          *(float4*)(sQ + t * 128 + 64 + part * 8 + i) = make_float4(q2[i], q2[i + 1], q2[i + 2], q2[i + 3]);
          *(float4*)(sK + t * 128 + part * 8 + i) = make_float4(k1[i], k1[i + 1], k1[i + 2], k1[i + 3]);
          *(float4*)(sK + t * 128 + 64 + part * 8 + i) = make_float4(k2[i], k2[i + 1], k2[i + 2], k2[i + 3]);
        }
        *(float4*)(sV + t * 64 + part * 8) = make_float4(v[0], v[1], v[2], v[3]);
        *(float4*)(sV + t * 64 + part * 8 + 4) = make_float4(v[4], v[5], v[6], v[7]);
        if (part == 0) *(float4*)(sSc + t * 4) = make_float4(c_a, 1.0f, qk, 0.f);
      }
    }
    __syncthreads();
    if (MODE != 0 && ci + 1 < 68) prefetch(ci + 1);
    if (wid < 4) {
#pragma unroll 1
      for (int i = 0; i < 64; ++i) {
        const int ts = dir ? 63 - i : i;
        v2f kk[8], qq[8];
#pragma unroll
        for (int u = 0; u < 4; ++u) {
          float4 kx = *(const float4*)(sK + ts * 128 + u * 32 + l8 * 4);
          float4 qx = *(const float4*)(sQ + ts * 128 + u * 32 + l8 * 4);
          kk[2 * u] = (v2f){kx.x, kx.y}; kk[2 * u + 1] = (v2f){kx.z, kx.w};
          qq[2 * u] = (v2f){qx.x, qx.y}; qq[2 * u + 1] = (v2f){qx.z, qx.w};
        }
        const float4 sc = *(const float4*)(sSc + ts * 4);
        const float2 vv = *(const float2*)(sV + ts * 64 + col);
        const float a = sc.x, qk = sc.z;
        v2f aq0 = qq[0] * S0[0], aq1 = qq[0] * S1[0];
#pragma unroll
        for (int u = 1; u < 8; ++u) { aq0 += qq[u] * S0[u]; aq1 += qq[u] * S1[u]; }
        const float pq0 = reduce8(aq0.x + aq0.y), pq1 = reduce8(aq1.x + aq1.y);
        float vn0, vn1;
        if (MODE == 0) {
          v2f ak0 = kk[0] * S0[0], ak1 = kk[0] * S1[0];
#pragma unroll
          for (int u = 1; u < 8; ++u) { ak0 += kk[u] * S0[u]; ak1 += kk[u] * S1[u]; }
          const float pk0 = reduce8(ak0.x + ak0.y), pk1 = reduce8(ak1.x + ak1.y);
          vn0 = sc.y * (vv.x - a * pk0); vn1 = sc.y * (vv.y - a * pk1);
        } else {
          vn0 = vv.x; vn1 = vv.y;
        }
        const float o0 = a * pq0 + qk * vn0, o1 = a * pq1 + qk * vn1;
        const v2f a2 = (v2f){a, a}, v20 = (v2f){vn0, vn0}, v21 = (v2f){vn1, vn1};
#pragma unroll
        for (int u = 0; u < 8; ++u) { S0[u] = a2 * S0[u] + kk[u] * v20; S1[u] = a2 * S1[u] + kk[u] * v21; }
        if (l8 == 0) *(float2*)(sO + ts * 64 + col) = make_float2(o0, o1);
      }
    }
    __syncthreads();
    {
      float4 o0 = *(const float4*)(sO + t * 64 + part * 8), o1 = *(const float4*)(sO + t * 64 + part * 8 + 4);
      uint4 u; u.x = pack2(o0.x, o0.y); u.y = pack2(o0.z, o0.w); u.z = pack2(o1.x, o1.y); u.w = pack2(o1.z, o1.w);
      const int tf = t;
      *(uint4*)(od + ((size_t)rowbase + t0 + tf) * DM + ocol + part * 8) = u;
    }
  }
  __syncthreads();
}

__device__ __forceinline__ uint4 pack8bf(const float* x) {
  uint4 u; u.x = pack2(x[0], x[1]); u.y = pack2(x[2], x[3]); u.z = pack2(x[4], x[5]); u.w = pack2(x[6], x[7]); return u;
}
__device__ __forceinline__ void ret_item(const Params& P, int item, int j) {
  extern __shared__ __attribute__((aligned(16))) char smem[];
  u16* sQ = (u16*)smem;
  u16* sK = sQ + 64 * 136;
  u16* sKT = sK + 64 * 136;
  u16* sVT = sKT + 128 * 72;
  u16* sA = sVT + 128 * 72;
  u16* sOut = sA + 64 * 72;
  const int tid = TID(), lane = tid & 63, wid = tid >> 6, fr = lane & 15, fq = lane >> 4;
  const int dir = item & 1, hb = item >> 1, h = hb % 6, b = hb / 6;
  const int qc = 256 + h * 128, kc = 1024 + h * 128, vc = 1792 + h * 128, ocol = 256 + h * 128;
  const u16* p = (const u16*)(wsp(P) + OFF_R);
  u16* od = (u16*)(wsp(P) + OFF_OUTDIR) + (size_t)dir * MROWS * DM;
  float* sRope = (float*)(sOut + 64 * 136);
  {
    const float* rope_g = (const float*)(wsp(P) + OFF_ROPE);
    for (int i = tid; i < 1024; i += NT) *(float4*)(sRope + i * 4) = *(const float4*)(rope_g + i * 4);
  }
  const float* rope = sRope;
  const float lg = -expf(inp(P, I_RETLR)[(j * 2 + dir) * 6 + h]) * 1.4426950408889634f;
  f32x4 accS[8];
#pragma unroll
  for (int i = 0; i < 8; ++i) accS[i] = (f32x4){0.f, 0.f, 0.f, 0.f};
  const int tl_c = tid >> 3, part_c = tid & 7;
  uint4 rq0, rq1, rk0, rk1, rv0, rv1;
  auto prefetch = [&](int ci) {
    int t0, L, rowbase; bool isctx;
    chunk_map(ci, dir, b, t0, L, rowbase, isctx);
    const u16* pr = p + ((size_t)rowbase + t0 + tl_c) * AB_NP;
    rq0 = *(const uint4*)(pr + qc + part_c * 8);
    rq1 = *(const uint4*)(pr + qc + 64 + part_c * 8);
    rk0 = *(const uint4*)(pr + kc + part_c * 8);
    rk1 = *(const uint4*)(pr + kc + 64 + part_c * 8);
    rv0 = *(const uint4*)(pr + vc + part_c * 16);
    rv1 = *(const uint4*)(pr + vc + part_c * 16 + 8);
  };
  prefetch(0);
  __syncthreads();
  for (int ci = 0; ci < 68; ++ci) {
    int t0, L, rowbase; bool isctx;
    chunk_map(ci, dir, b, t0, L, rowbase, isctx);
    int tl = tl_c, part = part_c;
    asm volatile("" : "+v"(tl), "+v"(part));
    const int ip = dir ? 63 - tl : tl;
    {
      const int tt = t0 + tl;
      float q1[8], q2[8], k1[8], k2[8];
      unpack8(rq0, q1); unpack8(rq1, q2); unpack8(rk0, k1); unpack8(rk1, k2);
      if (!isctx) {
        const int pos = part < 4 ? (tt >> 6) : (tt & 63);
        const int f0 = (part & 3) * 8;
#pragma unroll
        for (int i = 0; i < 8; ++i) {
          float2 cs = *(const float2*)(rope + (pos * 32 + f0 + i) * 2);
          float a = q1[i], bb = q2[i];
          q1[i] = a * cs.x - bb * cs.y; q2[i] = a * cs.y + bb * cs.x;
          a = k1[i]; bb = k2[i];
          k1[i] = a * cs.x - bb * cs.y; k2[i] = a * cs.y + bb * cs.x;
        }
      }
#pragma unroll
      for (int i = 0; i < 8; ++i) { k1[i] *= 0.08838834764831845f; k2[i] *= 0.08838834764831845f; }
      *(uint4*)(sQ + ip * 136 + part * 8) = pack8bf(q1);
      *(uint4*)(sQ + ip * 136 + 64 + part * 8) = pack8bf(q2);
      *(uint4*)(sK + ip * 136 + part * 8) = pack8bf(k1);
      *(uint4*)(sK + ip * 136 + 64 + part * 8) = pack8bf(k2);
      const float dk = exp2f((float)(63 - ip) * lg);
#pragma unroll
      for (int u = 0; u < 8; ++u) {
        sKT[(part * 8 + u) * 72 + ip] = f2bf(k1[u] * dk);
        sKT[(64 + part * 8 + u) * 72 + ip] = f2bf(k2[u] * dk);
      }
      const unsigned vw[8] = {rv0.x, rv0.y, rv0.z, rv0.w, rv1.x, rv1.y, rv1.z, rv1.w};
#pragma unroll
      for (int u = 0; u < 8; ++u) {
        sVT[(part * 16 + 2 * u) * 72 + ip] = (u16)(vw[u] & 0xffffu);
        sVT[(part * 16 + 2 * u + 1) * 72 + ip] = (u16)(vw[u] >> 16);
      }
    }
    __syncthreads();
    if (ci + 1 < 68) prefetch(ci + 1);
#pragma unroll
    for (int tt = 0; tt < 2; ++tt) {
      const int tile = wid * 2 + tt, mi = tile >> 2, nj = tile & 3;
      f32x4 acc = (f32x4){0.f, 0.f, 0.f, 0.f};
      if (nj <= mi) {
#pragma unroll
        for (int kb = 0; kb < 4; ++kb) {
          bf16x8 a = *reinterpret_cast<const bf16x8*>(sQ + (mi * 16 + fr) * 136 + kb * 32 + fq * 8);
          bf16x8 bb = *reinterpret_cast<const bf16x8*>(sK + (nj * 16 + fr) * 136 + kb * 32 + fq * 8);
          acc = __builtin_amdgcn_mfma_f32_16x16x32_bf16(a, bb, acc, 0, 0, 0);
        }
      }
#pragma unroll
      for (int rr = 0; rr < 4; ++rr) {
        const int i = mi * 16 + fq * 4 + rr, jx = nj * 16 + fr;
        const float val = (jx <= i) ? acc[rr] * exp2f((float)(i - jx) * lg) : 0.0f;
        sA[i * 72 + jx] = f2bf(val);
      }
    }
    __syncthreads();
    {
      const int e0 = wid * 16;
      f32x4 o[4];
#pragma unroll
      for (int m = 0; m < 4; ++m) o[m] = (f32x4){0.f, 0.f, 0.f, 0.f};
#pragma unroll
      for (int kb = 0; kb < 4; ++kb) {
        uint4 sb;
        sb.x = pack2(accS[2 * kb][0], accS[2 * kb][1]); sb.y = pack2(accS[2 * kb][2], accS[2 * kb][3]);
        sb.z = pack2(accS[2 * kb + 1][0], accS[2 * kb + 1][1]); sb.w = pack2(accS[2 * kb + 1][2], accS[2 * kb + 1][3]);
        const bf16x8 bS = __builtin_bit_cast(bf16x8, sb);
#pragma unroll
        for (int m = 0; m < 4; ++m) {
          uint2 a0 = *(const uint2*)(sQ + (m * 16 + fr) * 136 + kb * 32 + fq * 4);
          uint2 a1 = *(const uint2*)(sQ + (m * 16 + fr) * 136 + kb * 32 + 16 + fq * 4);
          uint4 au; au.x = a0.x; au.y = a0.y; au.z = a1.x; au.w = a1.y;
          o[m] = __builtin_amdgcn_mfma_f32_16x16x32_bf16(__builtin_bit_cast(bf16x8, au), bS, o[m], 0, 0, 0);
        }
      }
#pragma unroll
      for (int m = 0; m < 4; ++m)
#pragma unroll
        for (int rr = 0; rr < 4; ++rr) o[m][rr] *= exp2f((float)(m * 16 + fq * 4 + rr + 1) * lg);
      bf16x8 bV[2];
#pragma unroll
      for (int jb = 0; jb < 2; ++jb) bV[jb] = *reinterpret_cast<const bf16x8*>(sVT + (e0 + fr) * 72 + jb * 32 + fq * 8);
#pragma unroll
      for (int m = 0; m < 4; ++m)
#pragma unroll
        for (int jb = 0; jb < 2; ++jb) {
          bf16x8 a = *reinterpret_cast<const bf16x8*>(sA + (m * 16 + fr) * 72 + jb * 32 + fq * 8);
          o[m] = __builtin_amdgcn_mfma_f32_16x16x32_bf16(a, bV[jb], o[m], 0, 0, 0);
        }
#pragma unroll
      for (int m = 0; m < 4; ++m)
#pragma unroll
        for (int rr = 0; rr < 4; ++rr) sOut[(m * 16 + fq * 4 + rr) * 136 + e0 + fr] = f2bf(o[m][rr]);
      const float cd = exp2f(64.0f * lg);
#pragma unroll
      for (int td = 0; td < 8; ++td) {
        accS[td][0] *= cd; accS[td][1] *= cd; accS[td][2] *= cd; accS[td][3] *= cd;
#pragma unroll
        for (int jb = 0; jb < 2; ++jb) {
          bf16x8 a = *reinterpret_cast<const bf16x8*>(sKT + (td * 16 + fr) * 72 + jb * 32 + fq * 8);
          accS[td] = __builtin_amdgcn_mfma_f32_16x16x32_bf16(a, bV[jb], accS[td], 0, 0, 0);
        }
      }
    }
    __syncthreads();
    {
      uint4 u0 = *(const uint4*)(sOut + ip * 136 + part * 16), u1 = *(const uint4*)(sOut + ip * 136 + part * 16 + 8);
      u16* dst = od + ((size_t)rowbase + t0 + tl) * DM + ocol + part * 16;
      *(uint4*)dst = u0; *(uint4*)(dst + 8) = u1;
    }
  }
  __syncthreads();
}

__device__ __forceinline__ void shiftmix8(uint4 c, uint4 m, uint4 n, const float* mu, float* o) {
  float cf[8], mf[8], nf[8];
  unpack8(c, cf); unpack8(m, mf); unpack8(n, nf);
  float4 m0 = *(const float4*)mu, m1 = *(const float4*)(mu + 4);
  float mv[8] = {m0.x, m0.y, m0.z, m0.w, m1.x, m1.y, m1.z, m1.w};
#pragma unroll
  for (int i = 0; i < 8; ++i) o[i] = cf[i] + mv[i] * (0.5f * (mf[i] + nf[i]) - cf[i]);
}
__device__ __forceinline__ float shift8(const u16* pc, const u16* pm, const u16* pp, const float* mu, float* o) {
  shiftmix8(*(const uint4*)pc, ldz4(pm ? pm : pc, pm != nullptr), ldz4(pp ? pp : pc, pp != nullptr), mu, o);
  return 0.f;
}

__device__ __forceinline__ void rwkv_item(const Params& P, int item, int j) {
  extern __shared__ __attribute__((aligned(16))) char smem[];
  float* sAv = (float*)smem;
  float* sRW = sAv + 4096;
  float* sW = sRW + 4096;
  float* sBv = sW + 4096;
  float* sKD = sBv + 4096;
  float* sV = sKD + 4096;
  float* sY = sV + 4096;
  float* sSc = sY + 4096;
  float* sLin = sSc + 256;
  float* sWup = sLin + 4096;
  float* sAup = sWup + 2048;
  const int tid = TID(), lane = tid & 63, wid = tid >> 6;
  const int chain = item, dir = chain & 1, hb = chain >> 1, h = hb & 7, b = hb >> 3;
  const u16* p = (const u16*)(wsp(P) + OFF_R);
  u16* od = (u16*)(wsp(P) + OFF_OUTDIR) + (size_t)dir * MROWS * DM;
  float* bonus = (float*)(wsp(P) + OFF_BONUS) + (size_t)dir * MROWS * 8;
  const float* mu = inp(P, I_MU) + (size_t)j * 1760;
  {
    const float* wup = inp(P, I_WUP) + (size_t)(j * 2 + dir) * 32 * 512;
    const float* aup = inp(P, I_AUP) + (size_t)(j * 2 + dir) * 32 * 512;
    for (int i = tid; i < 2048; i += NT) {
      int l = i >> 6, c = i & 63;
      sWup[i] = wup[l * 512 + h * 64 + c];
      sAup[i] = aup[l * 512 + h * 64 + c];
    }
  }
  v2f S0[4], S1[4];
#pragma unroll
  for (int i = 0; i < 4; ++i) { S0[i] = (v2f){0.f, 0.f}; S1[i] = (v2f){0.f, 0.f}; }
  const int l8 = lane & 7, rowi = (wid & 3) * 16 + (lane >> 3) * 2;
  constexpr int RB = 2064;
  const int t_c = tid >> 3, j8_c = tid & 7;
  uint4 pr_[3], pk_[3], pv_[3];
  uint2 pw_[3], pa_[3];
  auto prefetch = [&](int ci) {
    int t0, L, rowbase; bool isctx;
    chunk_map(ci, dir, b, t0, L, rowbase, isctx);
    int t = t_c, j8 = j8_c;
    asm volatile("" : "+v"(t), "+v"(j8));
    const int hc = h * 64 + j8 * 8;
    const int cw = 1536 + dir * 32 + j8 * 4, ca = 1600 + dir * 32 + j8 * 4;
    const int tt = t0 + t;
#pragma unroll
    for (int d = 0; d < 3; ++d) {
      const int ts = tt + d - 1;
      const bool ok = ts >= 0 && ts < L;
      const u16* pc = p + ((size_t)rowbase + (ok ? ts : tt)) * CD_NP + RB;
      pr_[d] = ldz4(pc + hc, ok);
      pk_[d] = ldz4(pc + 512 + hc, ok);
      pv_[d] = ldz4(pc + 1024 + hc, ok);
      pw_[d] = ldz2(pc + cw, ok);
      pa_[d] = ldz2(pc + ca, ok);
    }
  };
  prefetch(0);
  __syncthreads();
  for (int ci = 0; ci < 68; ++ci) {
    int t0, L, rowbase; bool isctx;
    chunk_map(ci, dir, b, t0, L, rowbase, isctx);
    int t = t_c, j8 = j8_c;
    asm volatile("" : "+v"(t), "+v"(j8));
    const int hc = h * 64 + j8 * 8;
    const int cw = 1536 + dir * 32 + j8 * 4, ca = 1600 + dir * 32 + j8 * 4;
    const size_t row = (size_t)rowbase + t0 + t;
    {
      float c[4], m[4], n[4];
      c[0] = lo16(pw_[1].x); c[1] = hi16(pw_[1].x); c[2] = lo16(pw_[1].y); c[3] = hi16(pw_[1].y);
      m[0] = lo16(pw_[0].x); m[1] = hi16(pw_[0].x); m[2] = lo16(pw_[0].y); m[3] = hi16(pw_[0].y);
      n[0] = lo16(pw_[2].x); n[1] = hi16(pw_[2].x); n[2] = lo16(pw_[2].y); n[3] = hi16(pw_[2].y);
#pragma unroll
      for (int i = 0; i < 4; ++i) sLin[t * 64 + j8 * 4 + i] = tanhf(c[i] + mu[cw + i] * (0.5f * (m[i] + n[i]) - c[i]));
      c[0] = lo16(pa_[1].x); c[1] = hi16(pa_[1].x); c[2] = lo16(pa_[1].y); c[3] = hi16(pa_[1].y);
      m[0] = lo16(pa_[0].x); m[1] = hi16(pa_[0].x); m[2] = lo16(pa_[0].y); m[3] = hi16(pa_[0].y);
      n[0] = lo16(pa_[2].x); n[1] = hi16(pa_[2].x); n[2] = lo16(pa_[2].y); n[3] = hi16(pa_[2].y);
#pragma unroll
      for (int i = 0; i < 4; ++i) sLin[t * 64 + 32 + j8 * 4 + i] = c[i] + mu[ca + i] * (0.5f * (m[i] + n[i]) - c[i]);
    }
    float r[8], k[8], v[8];
    shiftmix8(pr_[1], pr_[0], pr_[2], mu + hc, r);
    shiftmix8(pk_[1], pk_[0], pk_[2], mu + 512 + hc, k);
    shiftmix8(pv_[1], pv_[0], pv_[2], mu + 1024 + hc, v);
    __syncthreads();
    {
      float lw[8], la[8];
      {
        const float* w0 = inp(P, I_W0) + (size_t)(j * 2 + dir) * 512 + hc;
        const float* a0 = inp(P, I_A0) + (size_t)(j * 2 + dir) * 512 + hc;
#pragma unroll
        for (int i = 0; i < 8; ++i) { lw[i] = w0[i]; la[i] = a0[i]; }
      }
#pragma unroll 4
      for (int l = 0; l < 32; ++l) {
        float x = sLin[t * 64 + l], y = sLin[t * 64 + 32 + l];
        float4 wa = *(const float4*)(sWup + l * 64 + j8 * 8), wb = *(const float4*)(sWup + l * 64 + j8 * 8 + 4);
        float4 aa = *(const float4*)(sAup + l * 64 + j8 * 8), ab = *(const float4*)(sAup + l * 64 + j8 * 8 + 4);
        lw[0] += x * wa.x; lw[1] += x * wa.y; lw[2] += x * wa.z; lw[3] += x * wa.w;
        lw[4] += x * wb.x; lw[5] += x * wb.y; lw[6] += x * wb.z; lw[7] += x * wb.w;
        la[0] += y * aa.x; la[1] += y * aa.y; la[2] += y * aa.z; la[3] += y * aa.w;
        la[4] += y * ab.x; la[5] += y * ab.y; la[6] += y * ab.z; la[7] += y * ab.w;
      }
      const float* kkp = inp(P, I_KK) + (size_t)j * 512 + hc;
      const float* kap = inp(P, I_KA) + (size_t)j * 512 + hc;
      const float* rkp = inp(P, I_RK) + (size_t)(j * 8 + h) * 64 + j8 * 8;
      float kx[8], ss = 0.f;
#pragma unroll
      for (int i = 0; i < 8; ++i) { kx[i] = k[i] * kkp[i]; ss += kx[i] * kx[i]; }
      ss = reduce8(ss);
      float rn = rsqrtf(ss + 1e-6f);
      float av[8], rw[8], wv[8], bv[8], kd[8];
      float rb = 0.f, rk = 0.f, bon = 0.f;
      float one = 1.0f;
      asm volatile("" : "+v"(one));
#pragma unroll
      for (int i = 0; i < 8; ++i) {
        float w = __expf(-0.6065306597126334f * __builtin_amdgcn_rcpf(one + __expf(-lw[i])));
        float aa = __builtin_amdgcn_rcpf(one + __expf(-la[i]));
        float kk = kx[i] * rn;
        kd[i] = k[i] * (one + (aa - one) * kap[i]);
        av[i] = -kk; bv[i] = kk * aa; rw[i] = r[i] * w; wv[i] = w;
        rb += r[i] * bv[i]; rk += r[i] * kd[i]; bon += r[i] * kd[i] * rkp[i];
      }
      rb = reduce8(rb); rk = reduce8(rk); bon = reduce8(bon);
      const int o = t * 64 + j8 * 8;
      *(float4*)(sAv + o) = make_float4(av[0], av[1], av[2], av[3]); *(float4*)(sAv + o + 4) = make_float4(av[4], av[5], av[6], av[7]);
      *(float4*)(sRW + o) = make_float4(rw[0], rw[1], rw[2], rw[3]); *(float4*)(sRW + o + 4) = make_float4(rw[4], rw[5], rw[6], rw[7]);
      *(float4*)(sW + o) = make_float4(wv[0], wv[1], wv[2], wv[3]); *(float4*)(sW + o + 4) = make_float4(wv[4], wv[5], wv[6], wv[7]);
      *(float4*)(sBv + o) = make_float4(bv[0], bv[1], bv[2], bv[3]); *(float4*)(sBv + o + 4) = make_float4(bv[4], bv[5], bv[6], bv[7]);
      *(float4*)(sKD + o) = make_float4(kd[0], kd[1], kd[2], kd[3]); *(float4*)(sKD + o + 4) = make_float4(kd[4], kd[5], kd[6], kd[7]);
      *(float4*)(sV + o) = make_float4(v[0], v[1], v[2], v[3]); *(float4*)(sV + o + 4) = make_float4(v[4], v[5], v[6], v[7]);
      if (j8 == 0) {
        *(float2*)(sSc + t * 4) = make_float2(rb, rk);
        bonus[row * 8 + h] = bon;
      }
    }
    __syncthreads();
    if (ci + 1 < 68) prefetch(ci + 1);
    if (wid < 4) {
#pragma unroll 2
      for (int i = 0; i < 64; ++i) {
        const int ts = dir ? 63 - i : i;
        v2f a2[4], r2[4], w2[4], b2[4], k2[4];
#pragma unroll
        for (int u = 0; u < 2; ++u) {
          const int o = ts * 64 + u * 32 + l8 * 4;
          float4 x;
          x = *(const float4*)(sAv + o); a2[2 * u] = (v2f){x.x, x.y}; a2[2 * u + 1] = (v2f){x.z, x.w};
          x = *(const float4*)(sRW + o); r2[2 * u] = (v2f){x.x, x.y}; r2[2 * u + 1] = (v2f){x.z, x.w};
          x = *(const float4*)(sW + o); w2[2 * u] = (v2f){x.x, x.y}; w2[2 * u + 1] = (v2f){x.z, x.w};
          x = *(const float4*)(sBv + o); b2[2 * u] = (v2f){x.x, x.y}; b2[2 * u + 1] = (v2f){x.z, x.w};
          x = *(const float4*)(sKD + o); k2[2 * u] = (v2f){x.x, x.y}; k2[2 * u + 1] = (v2f){x.z, x.w};
        }
        const float2 sc = *(const float2*)(sSc + ts * 4);
        const float2 vv = *(const float2*)(sV + ts * 64 + rowi);
        v2f pa0 = S0[0] * a2[0], py0 = S0[0] * r2[0], pa1 = S1[0] * a2[0], py1 = S1[0] * r2[0];
#pragma unroll
        for (int u = 1; u < 4; ++u) { pa0 += S0[u] * a2[u]; py0 += S0[u] * r2[u]; pa1 += S1[u] * a2[u]; py1 += S1[u] * r2[u]; }
        const float psa0 = reduce8(pa0.x + pa0.y), pyy0 = reduce8(py0.x + py0.y);
        const float psa1 = reduce8(pa1.x + pa1.y), pyy1 = reduce8(py1.x + py1.y);
        const float y0 = pyy0 + psa0 * sc.x + vv.x * sc.y, y1 = pyy1 + psa1 * sc.x + vv.y * sc.y;
        const v2f ps0 = (v2f){psa0, psa0}, ps1 = (v2f){psa1, psa1}, vv0 = (v2f){vv.x, vv.x}, vv1 = (v2f){vv.y, vv.y};
#pragma unroll
        for (int u = 0; u < 4; ++u) {
          S0[u] = S0[u] * w2[u] + ps0 * b2[u] + vv0 * k2[u];
          S1[u] = S1[u] * w2[u] + ps1 * b2[u] + vv1 * k2[u];
        }
        if (l8 == 0) *(float2*)(sY + ts * 64 + rowi) = make_float2(y0, y1);
      }
    }
    __syncthreads();
    {
      float4 o0 = *(const float4*)(sY + t * 64 + j8 * 8), o1 = *(const float4*)(sY + t * 64 + j8 * 8 + 4);
      uint4 u; u.x = pack2(o0.x, o0.y); u.y = pack2(o0.z, o0.w); u.z = pack2(o1.x, o1.y); u.w = pack2(o1.z, o1.w);
      *(uint4*)(od + row * DM + 512 + h * 64 + j8 * 8) = u;
    }
  }
  __syncthreads();
}

__device__ __forceinline__ void chunk_map32(int ci, int dir, int b, int& t0, int& L, int& rowbase) {
  const bool isctx = ci < 8;
  const int cc = isctx ? ci : ci - 8;
  const int nch = isctx ? 8 : 128;
  const int cn = dir ? nch - 1 - cc : cc;
  t0 = cn * 32;
  L = isctx ? 256 : 4096;
  rowbase = isctx ? MLAT + b * 256 : b * 4096;
}

__device__ __forceinline__ void gdn_item2(const Params& P, int item, int j) {
  extern __shared__ __attribute__((aligned(16))) char smem[];
  float* sCW = (float*)smem;
  float* sBuf = sCW + 1600;
  float* sOb = sBuf + 2 * 10368;
  const int tid = TID(), lane = tid & 63, wid = tid >> 6;
  const int half = item & 1, chain = item >> 1, dir = chain & 1, hb = chain >> 1;
  const int h = hb & 3, b = hb >> 2;
  const int qc = h * 128, kc = 512 + h * 128, vc = 1024 + h * 128 + half * 64, ocol = h * 128 + half * 64;
  const u16* p = (const u16*)(wsp(P) + OFF_R);
  u16* od = (u16*)(wsp(P) + OFF_OUTDIR) + (size_t)dir * MROWS * DM;
  const float c_a = -expf(inp(P, I_ALOG)[(j * 2 + dir) * 4 + h]);
  const float c_b = inp(P, I_DTB)[(j * 2 + dir) * 4 + h];
  {
    const float* cw = inp(P, I_CONVW) + (size_t)j * 5 * 1536;
    for (int i = tid; i < 1600; i += NT) {
      float v;
      if (i < 640) { int tap = i >> 7, c = i & 127; v = cw[tap * 1536 + h * 128 + c]; }
      else if (i < 1280) { int q = i - 640; int tap = q >> 7, c = q & 127; v = cw[tap * 1536 + 512 + h * 128 + c]; }
      else { int q = i - 1280; int tap = q >> 6, c = q & 63; v = cw[tap * 1536 + 1024 + h * 128 + half * 64 + c]; }
      sCW[i] = v;
    }
  }
  __syncthreads();
  const bool consumer = wid < 4;
  const int tp_c = (tid - 256) >> 3, part_c = tid & 7;
  auto prep = [&](int ci) {
    float* bufp = sBuf + (ci & 1) * 10368;
    float* sSc = bufp; float* sV = bufp + 128; float* sK = sV + 2048; float* sQ = sK + 4096;
    int t0, L, rowbase;
    chunk_map32(ci, dir, b, t0, L, rowbase);
    int t = tp_c, part = part_c;
    asm volatile("" : "+v"(t), "+v"(part));
    const int tt = t0 + t;
    const u16* prc = p + ((size_t)rowbase + tt) * CD_NP;
    const float ain = bf2f(prc[2048 + dir * 4 + h]), bin = bf2f(prc[2056 + dir * 4 + h]);
    float q[16], k[16], v[8];
#pragma unroll
    for (int i = 0; i < 16; ++i) { q[i] = 0.f; k[i] = 0.f; }
#pragma unroll
    for (int i = 0; i < 8; ++i) v[i] = 0.f;
    {
      uint4 r0[5], r1[5];
#pragma unroll
      for (int tap = 0; tap < 5; ++tap) {
        const int ts = tt + tap - 2;
        const bool ok = ts >= 0 && ts < L;
        const u16* pr = p + ((size_t)rowbase + (ok ? ts : tt)) * CD_NP;
        r0[tap] = ldz4(pr + qc + part * 16, ok);
        r1[tap] = ldz4(pr + qc + part * 16 + 8, ok);
      }
#pragma unroll
      for (int tap = 0; tap < 5; ++tap) {
        float x[16];
        unpack8(r0[tap], x); unpack8(r1[tap], x + 8);
#pragma unroll
        for (int i = 0; i < 16; ++i) q[i] += x[i] * sCW[tap * 128 + part * 16 + i];
      }
    }
    asm volatile("" ::: "memory");
    {
      uint4 r0[5], r1[5];
#pragma unroll
      for (int tap = 0; tap < 5; ++tap) {
        const int ts = tt + tap - 2;
        const bool ok = ts >= 0 && ts < L;
        const u16* pr = p + ((size_t)rowbase + (ok ? ts : tt)) * CD_NP;
        r0[tap] = ldz4(pr + kc + part * 16, ok);
        r1[tap] = ldz4(pr + kc + part * 16 + 8, ok);
      }
#pragma unroll
      for (int tap = 0; tap < 5; ++tap) {
        float x[16];
        unpack8(r0[tap], x); unpack8(r1[tap], x + 8);
#pragma unroll
        for (int i = 0; i < 16; ++i) k[i] += x[i] * sCW[640 + tap * 128 + part * 16 + i];
      }
    }
    asm volatile("" ::: "memory");
    {
      uint4 r0[5];
#pragma unroll
      for (int tap = 0; tap < 5; ++tap) {
        const int ts = tt + tap - 2;
        const bool ok = ts >= 0 && ts < L;
        const u16* pr = p + ((size_t)rowbase + (ok ? ts : tt)) * CD_NP;
        r0[tap] = ldz4(pr + vc + part * 8, ok);
      }
#pragma unroll
      for (int tap = 0; tap < 5; ++tap) {
        float x[8];
        unpack8(r0[tap], x);
#pragma unroll
        for (int i = 0; i < 8; ++i) v[i] += x[i] * sCW[1280 + tap * 64 + part * 8 + i];
      }
    }
    float sq = 0.f, sk = 0.f;
#pragma unroll
    for (int i = 0; i < 16; ++i) { q[i] = siluf_(q[i]); k[i] = siluf_(k[i]); sq += q[i] * q[i]; sk += k[i] * k[i]; }
    sq = reduce8(sq); sk = reduce8(sk);
    const float rq = rsqrtf(sq + 1e-6f) * 0.08838834764831845f, rk = rsqrtf(sk + 1e-6f);
    float qk = 0.f;
#pragma unroll
    for (int i = 0; i < 16; ++i) { q[i] *= rq; k[i] *= rk; qk += q[i] * k[i]; }
    qk = reduce8(qk);
#pragma unroll
    for (int i = 0; i < 16; i += 4) {
      *(float4*)(sQ + t * 128 + part * 16 + i) = make_float4(q[i], q[i + 1], q[i + 2], q[i + 3]);
      *(float4*)(sK + t * 128 + part * 16 + i) = make_float4(k[i], k[i + 1], k[i + 2], k[i + 3]);
    }
    *(float4*)(sV + t * 64 + part * 8) = make_float4(siluf_(v[0]), siluf_(v[1]), siluf_(v[2]), siluf_(v[3]));
    *(float4*)(sV + t * 64 + part * 8 + 4) = make_float4(siluf_(v[4]), siluf_(v[5]), siluf_(v[6]), siluf_(v[7]));
    if (part == 0) *(float4*)(sSc + t * 4) = make_float4(__expf(c_a * softplusf_(ain + c_b)), sigmoidf_(bin), qk, 0.f);
  };
  auto flush = [&](int ci) {
    const float* sO = sOb + (ci & 1) * 2048;
    int t0, L, rowbase;
    chunk_map32(ci, dir, b, t0, L, rowbase);
    int t = tp_c, part = part_c;
    asm volatile("" : "+v"(t), "+v"(part));
    float4 o0 = *(const float4*)(sO + t * 64 + part * 8), o1 = *(const float4*)(sO + t * 64 + part * 8 + 4);
    uint4 u; u.x = pack2(o0.x, o0.y); u.y = pack2(o0.z, o0.w); u.z = pack2(o1.x, o1.y); u.w = pack2(o1.z, o1.w);
    *(uint4*)(od + ((size_t)rowbase + t0 + t) * DM + ocol + part * 8) = u;
  };
  v2f S0[8], S1[8];
#pragma unroll
  for (int i = 0; i < 8; ++i) { S0[i] = (v2f){0.f, 0.f}; S1[i] = (v2f){0.f, 0.f}; }
  const int l8 = lane & 7, col = (wid & 3) * 16 + (lane >> 3) * 2;
  if (!consumer) prep(0);
  __syncthreads();
  for (int ci = 0; ci < 136; ++ci) {
    if (consumer) {
      const float* bufp = sBuf + (ci & 1) * 10368;
      const float* sSc = bufp; const float* sV = bufp + 128; const float* sK = sV + 2048; const float* sQ = sK + 4096;
      float* sO = sOb + (ci & 1) * 2048;
#pragma unroll 2
      for (int i = 0; i < 32; ++i) {
        const int ts = dir ? 31 - i : i;
        v2f kk[8], qq[8];
#pragma unroll
        for (int u = 0; u < 4; ++u) {
          float4 kx = *(const float4*)(sK + ts * 128 + u * 32 + l8 * 4);
          float4 qx = *(const float4*)(sQ + ts * 128 + u * 32 + l8 * 4);
          kk[2 * u] = (v2f){kx.x, kx.y}; kk[2 * u + 1] = (v2f){kx.z, kx.w};
          qq[2 * u] = (v2f){qx.x, qx.y}; qq[2 * u + 1] = (v2f){qx.z, qx.w};
        }
        const float4 sc = *(const float4*)(sSc + ts * 4);
        const float2 vv = *(const float2*)(sV + ts * 64 + col);
        const float a = sc.x, qk = sc.z;
        v2f aq0 = qq[0] * S0[0], aq1 = qq[0] * S1[0], ak0 = kk[0] * S0[0], ak1 = kk[0] * S1[0];
#pragma unroll
        for (int u = 1; u < 8; ++u) { aq0 += qq[u] * S0[u]; aq1 += qq[u] * S1[u]; ak0 += kk[u] * S0[u]; ak1 += kk[u] * S1[u]; }
        const float pq0 = reduce8(aq0.x + aq0.y), pq1 = reduce8(aq1.x + aq1.y);
        const float pk0 = reduce8(ak0.x + ak0.y), pk1 = reduce8(ak1.x + ak1.y);
        const float vn0 = sc.y * (vv.x - a * pk0), vn1 = sc.y * (vv.y - a * pk1);
        const float o0 = a * pq0 + qk * vn0, o1 = a * pq1 + qk * vn1;
        const v2f a2 = (v2f){a, a}, v20 = (v2f){vn0, vn0}, v21 = (v2f){vn1, vn1};
#pragma unroll
        for (int u = 0; u < 8; ++u) { S0[u] = a2 * S0[u] + kk[u] * v20; S1[u] = a2 * S1[u] + kk[u] * v21; }
        if (l8 == 0) *(float2*)(sO + ts * 64 + col) = make_float2(o0, o1);
      }
    } else {
      if (ci > 0) flush(ci - 1);
      if (ci + 1 < 136) prep(ci + 1);
    }
    __syncthreads();
  }
  if (!consumer) flush(135);
  __syncthreads();
}

__device__ __forceinline__ void rwkv_item2(const Params& P, int item, int j) {
  extern __shared__ __attribute__((aligned(16))) char smem[];
  float* sWup = (float*)smem;
  float* sAup = sWup + 2048;
  float* sLin = sAup + 2048;
  float* sBuf = sLin + 2048;
  float* sYb = sBuf + 2 * 12416;
  const int tid = TID(), lane = tid & 63, wid = tid >> 6;
  const int chain = item, dir = chain & 1, hb = chain >> 1, h = hb & 7, b = hb >> 3;
  const u16* p = (const u16*)(wsp(P) + OFF_R);
  u16* od = (u16*)(wsp(P) + OFF_OUTDIR) + (size_t)dir * MROWS * DM;
  float* bonus = (float*)(wsp(P) + OFF_BONUS) + (size_t)dir * MROWS * 8;
  const float* mu = inp(P, I_MU) + (size_t)j * 1760;
  {
    const float* wup = inp(P, I_WUP) + (size_t)(j * 2 + dir) * 32 * 512;
    const float* aup = inp(P, I_AUP) + (size_t)(j * 2 + dir) * 32 * 512;
    for (int i = tid; i < 2048; i += NT) {
      int l = i >> 6, c = i & 63;
      sWup[i] = wup[l * 512 + h * 64 + c];
      sAup[i] = aup[l * 512 + h * 64 + c];
    }
  }
  __syncthreads();
  constexpr int RB = 2064;
  const bool consumer = wid < 4;
  const int tp_c = (tid - 256) >> 3, j8_c = tid & 7;
  auto prep = [&](int ci) {
    float* bufp = sBuf + (ci & 1) * 12416;
    float* sSc = bufp; float* sV = bufp + 128; float* sAv = sV + 2048; float* sRW = sAv + 2048;
    float* sW = sRW + 2048; float* sBv = sW + 2048; float* sKD = sBv + 2048;
    int t0, L, rowbase;
    chunk_map32(ci, dir, b, t0, L, rowbase);
    int t = tp_c, j8 = j8_c;
    asm volatile("" : "+v"(t), "+v"(j8));
    const int hc = h * 64 + j8 * 8;
    const int cw = 1536 + dir * 32 + j8 * 4, ca = 1600 + dir * 32 + j8 * 4;
    const int tt = t0 + t;
    const size_t row = (size_t)rowbase + tt;
    uint4 pr_[3], pk_[3], pv_[3];
    uint2 pw_[3], pa_[3];
#pragma unroll
    for (int d = 0; d < 3; ++d) {
      const int ts = tt + d - 1;
      const bool ok = ts >= 0 && ts < L;
      const u16* pc = p + ((size_t)rowbase + (ok ? ts : tt)) * CD_NP + RB;
      pr_[d] = ldz4(pc + hc, ok);
      pk_[d] = ldz4(pc + 512 + hc, ok);
      pv_[d] = ldz4(pc + 1024 + hc, ok);
      pw_[d] = ldz2(pc + cw, ok);
      pa_[d] = ldz2(pc + ca, ok);
    }
    {
      float c[4], m[4], n[4];
      c[0] = lo16(pw_[1].x); c[1] = hi16(pw_[1].x); c[2] = lo16(pw_[1].y); c[3] = hi16(pw_[1].y);
      m[0] = lo16(pw_[0].x); m[1] = hi16(pw_[0].x); m[2] = lo16(pw_[0].y); m[3] = hi16(pw_[0].y);
      n[0] = lo16(pw_[2].x); n[1] = hi16(pw_[2].x); n[2] = lo16(pw_[2].y); n[3] = hi16(pw_[2].y);
#pragma unroll
      for (int i = 0; i < 4; ++i) sLin[t * 64 + j8 * 4 + i] = tanhf(c[i] + mu[cw + i] * (0.5f * (m[i] + n[i]) - c[i]));
      c[0] = lo16(pa_[1].x); c[1] = hi16(pa_[1].x); c[2] = lo16(pa_[1].y); c[3] = hi16(pa_[1].y);
      m[0] = lo16(pa_[0].x); m[1] = hi16(pa_[0].x); m[2] = lo16(pa_[0].y); m[3] = hi16(pa_[0].y);
      n[0] = lo16(pa_[2].x); n[1] = hi16(pa_[2].x); n[2] = lo16(pa_[2].y); n[3] = hi16(pa_[2].y);
#pragma unroll
      for (int i = 0; i < 4; ++i) sLin[t * 64 + 32 + j8 * 4 + i] = c[i] + mu[ca + i] * (0.5f * (m[i] + n[i]) - c[i]);
    }
    float r[8], k[8], v[8];
    shiftmix8(pr_[1], pr_[0], pr_[2], mu + hc, r);
    shiftmix8(pk_[1], pk_[0], pk_[2], mu + 512 + hc, k);
    shiftmix8(pv_[1], pv_[0], pv_[2], mu + 1024 + hc, v);
    __builtin_amdgcn_fence(__ATOMIC_RELEASE, "wavefront");
    __builtin_amdgcn_wave_barrier();
    __builtin_amdgcn_fence(__ATOMIC_ACQUIRE, "wavefront");
    float lw[8], la[8];
    {
      const float* w0 = inp(P, I_W0) + (size_t)(j * 2 + dir) * 512 + hc;
      const float* a0 = inp(P, I_A0) + (size_t)(j * 2 + dir) * 512 + hc;
#pragma unroll
      for (int i = 0; i < 8; ++i) { lw[i] = w0[i]; la[i] = a0[i]; }
    }
#pragma unroll 4
    for (int l = 0; l < 32; ++l) {
      float x = sLin[t * 64 + l], y = sLin[t * 64 + 32 + l];
      float4 wa = *(const float4*)(sWup + l * 64 + j8 * 8), wb = *(const float4*)(sWup + l * 64 + j8 * 8 + 4);
      float4 aa = *(const float4*)(sAup + l * 64 + j8 * 8), ab = *(const float4*)(sAup + l * 64 + j8 * 8 + 4);
      lw[0] += x * wa.x; lw[1] += x * wa.y; lw[2] += x * wa.z; lw[3] += x * wa.w;
      lw[4] += x * wb.x; lw[5] += x * wb.y; lw[6] += x * wb.z; lw[7] += x * wb.w;
      la[0] += y * aa.x; la[1] += y * aa.y; la[2] += y * aa.z; la[3] += y * aa.w;
      la[4] += y * ab.x; la[5] += y * ab.y; la[6] += y * ab.z; la[7] += y * ab.w;
    }
    const float* kkp = inp(P, I_KK) + (size_t)j * 512 + hc;
    const float* kap = inp(P, I_KA) + (size_t)j * 512 + hc;
    const float* rkp = inp(P, I_RK) + (size_t)(j * 8 + h) * 64 + j8 * 8;
    float kx[8], ss = 0.f;
#pragma unroll
    for (int i = 0; i < 8; ++i) { kx[i] = k[i] * kkp[i]; ss += kx[i] * kx[i]; }
    ss = reduce8(ss);
    const float rn = rsqrtf(ss + 1e-6f);
    float av[8], rw[8], wv[8], bv[8], kd[8];
    float rb = 0.f, rk = 0.f, bon = 0.f;
    float one = 1.0f;
    asm volatile("" : "+v"(one));
#pragma unroll
    for (int i = 0; i < 8; ++i) {
      float w = __expf(-0.6065306597126334f * __builtin_amdgcn_rcpf(one + __expf(-lw[i])));
      float aa = __builtin_amdgcn_rcpf(one + __expf(-la[i]));
      float kk = kx[i] * rn;
      kd[i] = k[i] * (one + (aa - one) * kap[i]);
      av[i] = -kk; bv[i] = kk * aa; rw[i] = r[i] * w; wv[i] = w;
      rb += r[i] * bv[i]; rk += r[i] * kd[i]; bon += r[i] * kd[i] * rkp[i];
    }
    rb = reduce8(rb); rk = reduce8(rk); bon = reduce8(bon);
    const int o = t * 64 + j8 * 8;
    *(float4*)(sAv + o) = make_float4(av[0], av[1], av[2], av[3]); *(float4*)(sAv + o + 4) = make_float4(av[4], av[5], av[6], av[7]);
    *(float4*)(sRW + o) = make_float4(rw[0], rw[1], rw[2], rw[3]); *(float4*)(sRW + o + 4) = make_float4(rw[4], rw[5], rw[6], rw[7]);
    *(float4*)(sW + o) = make_float4(wv[0], wv[1], wv[2], wv[3]); *(float4*)(sW + o + 4) = make_float4(wv[4], wv[5], wv[6], wv[7]);
    *(float4*)(sBv + o) = make_float4(bv[0], bv[1], bv[2], bv[3]); *(float4*)(sBv + o + 4) = make_float4(bv[4], bv[5], bv[6], bv[7]);
    *(float4*)(sKD + o) = make_float4(kd[0], kd[1], kd[2], kd[3]); *(float4*)(sKD + o + 4) = make_float4(kd[4], kd[5], kd[6], kd[7]);
    *(float4*)(sV + o) = make_float4(v[0], v[1], v[2], v[3]); *(float4*)(sV + o + 4) = make_float4(v[4], v[5], v[6], v[7]);
    if (j8 == 0) {
      *(float2*)(sSc + t * 4) = make_float2(rb, rk);
      bonus[row * 8 + h] = bon;
    }
  };
  auto flush = [&](int ci) {
    const float* sY = sYb + (ci & 1) * 2048;
    int t0, L, rowbase;
    chunk_map32(ci, dir, b, t0, L, rowbase);
    int t = tp_c, j8 = j8_c;
    asm volatile("" : "+v"(t), "+v"(j8));
    float4 o0 = *(const float4*)(sY + t * 64 + j8 * 8), o1 = *(const float4*)(sY + t * 64 + j8 * 8 + 4);
    uint4 u; u.x = pack2(o0.x, o0.y); u.y = pack2(o0.z, o0.w); u.z = pack2(o1.x, o1.y); u.w = pack2(o1.z, o1.w);
    *(uint4*)(od + ((size_t)rowbase + t0 + t) * DM + 512 + h * 64 + j8 * 8) = u;
  };
  v2f S0[4], S1[4];
#pragma unroll
  for (int i = 0; i < 4; ++i) { S0[i] = (v2f){0.f, 0.f}; S1[i] = (v2f){0.f, 0.f}; }
  const int l8 = lane & 7, rowi = (wid & 3) * 16 + (lane >> 3) * 2;
  if (!consumer) prep(0);
  __syncthreads();
  for (int ci = 0; ci < 136; ++ci) {
    if (consumer) {
      const float* bufp = sBuf + (ci & 1) * 12416;
      const float* sSc = bufp; const float* sV = bufp + 128; const float* sAv = sV + 2048; const float* sRW = sAv + 2048;
      const float* sW = sRW + 2048; const float* sBv = sW + 2048; const float* sKD = sBv + 2048;
      float* sY = sYb + (ci & 1) * 2048;
#pragma unroll 2
      for (int i = 0; i < 32; ++i) {
        const int ts = dir ? 31 - i : i;
        v2f a2[4], r2[4], w2[4], b2[4], k2[4];
#pragma unroll
        for (int u = 0; u < 2; ++u) {
          const int o = ts * 64 + u * 32 + l8 * 4;
          float4 x;
          x = *(const float4*)(sAv + o); a2[2 * u] = (v2f){x.x, x.y}; a2[2 * u + 1] = (v2f){x.z, x.w};
          x = *(const float4*)(sRW + o); r2[2 * u] = (v2f){x.x, x.y}; r2[2 * u + 1] = (v2f){x.z, x.w};
          x = *(const float4*)(sW + o); w2[2 * u] = (v2f){x.x, x.y}; w2[2 * u + 1] = (v2f){x.z, x.w};
          x = *(const float4*)(sBv + o); b2[2 * u] = (v2f){x.x, x.y}; b2[2 * u + 1] = (v2f){x.z, x.w};
          x = *(const float4*)(sKD + o); k2[2 * u] = (v2f){x.x, x.y}; k2[2 * u + 1] = (v2f){x.z, x.w};
        }
        const float2 sc = *(const float2*)(sSc + ts * 4);
        const float2 vv = *(const float2*)(sV + ts * 64 + rowi);
        v2f pa0 = S0[0] * a2[0], py0 = S0[0] * r2[0], pa1 = S1[0] * a2[0], py1 = S1[0] * r2[0];
#pragma unroll
        for (int u = 1; u < 4; ++u) { pa0 += S0[u] * a2[u]; py0 += S0[u] * r2[u]; pa1 += S1[u] * a2[u]; py1 += S1[u] * r2[u]; }
        const float psa0 = reduce8(pa0.x + pa0.y), pyy0 = reduce8(py0.x + py0.y);
        const float psa1 = reduce8(pa1.x + pa1.y), pyy1 = reduce8(py1.x + py1.y);
        const float y0 = pyy0 + psa0 * sc.x + vv.x * sc.y, y1 = pyy1 + psa1 * sc.x + vv.y * sc.y;
        const v2f ps0 = (v2f){psa0, psa0}, ps1 = (v2f){psa1, psa1}, vv0 = (v2f){vv.x, vv.x}, vv1 = (v2f){vv.y, vv.y};
#pragma unroll
        for (int u = 0; u < 4; ++u) {
          S0[u] = S0[u] * w2[u] + ps0 * b2[u] + vv0 * k2[u];
          S1[u] = S1[u] * w2[u] + ps1 * b2[u] + vv1 * k2[u];
        }
        if (l8 == 0) *(float2*)(sY + ts * 64 + rowi) = make_float2(y0, y1);
      }
    } else {
      if (ci > 0) flush(ci - 1);
      if (ci + 1 < 136) prep(ci + 1);
    }
    __syncthreads();
  }
  if (!consumer) flush(135);
  __syncthreads();
}

__device__ __forceinline__ void s5_item(const Params& P, int item, int j) {
  extern __shared__ __attribute__((aligned(16))) char smem[];
  u16* sGuB = (u16*)smem;
  u16* sBB = sGuB + 1024;
  u16* sCC = sBB + 2048;
  u16* sHb = sCC + 16 * 136;
  float* sH = (float*)(sHb + 64 * 136);
  const int tid = TID(), lane = tid & 63, wid = tid >> 6, fr = lane & 15, fq = lane >> 4;
  const int dir = item & 1, bg = item >> 1, g = bg & 15, b = bg >> 4;
  const float* tab = (const float*)(wsp(P) + OFF_S5TAB) + (size_t)(j * 2 + dir) * 34816;
  const u16* p = (const u16*)(wsp(P) + OFF_R);
  u16* od = (u16*)(wsp(P) + OFF_OUTDIR) + (size_t)dir * MROWS * DM;
  for (int i = tid; i < 2048; i += NT) {
    const int pp = i >> 4, c = i & 15;
    const float v = pp < 64 ? tab[2048 + (g * 64 + pp) * 16 + c] : tab[2048 + 16384 + (g * 64 + pp - 64) * 16 + c];
    sBB[i] = f2bf(v);
    const int cc = i >> 7, k = i & 127;
    const float w = k < 64 ? inp(P, I_CRE)[((size_t)(j * 16 + g) * 16 + cc) * 64 + k]
                           : -inp(P, I_CIM)[((size_t)(j * 16 + g) * 16 + cc) * 64 + (k - 64)];
    sCC[cc * 136 + k] = f2bf(w);
  }
  float lbr = 0.f, lbi = 0.f, hr = 0.f, hi = 0.f;
  if (tid < 64) { lbr = tab[g * 64 + tid]; lbi = tab[1024 + g * 64 + tid]; }
  const int idx_c = tid * 2;
  unsigned gu_pf;
  {
    int t0n, Ln, rowbasen; bool isctxn;
    chunk_map(0, dir, b, t0n, Ln, rowbasen, isctxn);
    gu_pf = *(const unsigned*)(p + ((size_t)rowbasen + t0n + (idx_c >> 4)) * AB_NP + g * 16 + (idx_c & 15));
  }
  __syncthreads();
  for (int ci = 0; ci < 68; ++ci) {
    int t0, L, rowbase; bool isctx;
    chunk_map(ci, dir, b, t0, L, rowbase, isctx);
    {
      const int tl = idx_c >> 4, c = idx_c & 15, ip = dir ? 63 - tl : tl;
      *(unsigned*)(sGuB + ip * 16 + c) = gu_pf;
    }
    __syncthreads();
    if (ci + 1 < 68) {
      int t0n, Ln, rowbasen; bool isctxn;
      chunk_map(ci + 1, dir, b, t0n, Ln, rowbasen, isctxn);
      gu_pf = *(const unsigned*)(p + ((size_t)rowbasen + t0n + (idx_c >> 4)) * AB_NP + g * 16 + (idx_c & 15));
    }
    {
      const uint4 z = make_uint4(0u, 0u, 0u, 0u);
      uint4 bu4 = *(const uint4*)(sBB + (wid * 16 + fr) * 16 + (fq & 1) * 8);
      if (fq >= 2) bu4 = z;
      const bf16x8 bop = __builtin_bit_cast(bf16x8, bu4);
#pragma unroll
      for (int m = 0; m < 4; ++m) {
        uint4 a4 = *(const uint4*)(sGuB + (m * 16 + fr) * 16 + (fq & 1) * 8);
        if (fq >= 2) a4 = z;
        f32x4 acc = (f32x4){0.f, 0.f, 0.f, 0.f};
        acc = __builtin_amdgcn_mfma_f32_16x16x32_bf16(__builtin_bit_cast(bf16x8, a4), bop, acc, 0, 0, 0);
#pragma unroll
        for (int rr = 0; rr < 4; ++rr) sH[(m * 16 + fq * 4 + rr) * 132 + wid * 16 + fr] = acc[rr];
      }
    }
    __syncthreads();
    if (tid < 64) {
#pragma unroll 1
      for (int b0 = 0; b0 < 64; b0 += 16) {
        float br[16], bi[16];
#pragma unroll
        for (int i = 0; i < 16; ++i) { br[i] = sH[(b0 + i) * 132 + tid]; bi[i] = sH[(b0 + i) * 132 + 64 + tid]; }
#pragma unroll
        for (int i = 0; i < 16; ++i) {
          float nr = lbr * hr - lbi * hi + br[i];
          float ni = lbr * hi + lbi * hr + bi[i];
          hr = nr; hi = ni;
          sHb[(b0 + i) * 136 + tid] = f2bf(hr);
          sHb[(b0 + i) * 136 + 64 + tid] = f2bf(hi);
        }
      }
    }
    __syncthreads();
    if (wid < 4) {
      f32x4 acc = (f32x4){0.f, 0.f, 0.f, 0.f};
#pragma unroll
      for (int kb = 0; kb < 4; ++kb) {
        bf16x8 a = *reinterpret_cast<const bf16x8*>(sHb + (wid * 16 + fr) * 136 + kb * 32 + fq * 8);
        bf16x8 bb = *reinterpret_cast<const bf16x8*>(sCC + fr * 136 + kb * 32 + fq * 8);
        acc = __builtin_amdgcn_mfma_f32_16x16x32_bf16(a, bb, acc, 0, 0, 0);
      }
#pragma unroll
      for (int rr = 0; rr < 4; ++rr) {
        const int i = wid * 16 + fq * 4 + rr, tok = dir ? 63 - i : i;
        od[((size_t)rowbase + t0 + tok) * DM + g * 16 + fr] = f2bf(acc[rr]);
      }
    }
  }
  __syncthreads();
}

__device__ __forceinline__ void scan_ab(const Params& P, int j) {
  const int nb = gridDim.x, bi = BID();
  const bool split = nb == 256;
  for (int it = bi; it < 96; it += nb) ret_item(P, it, j);
  const int s0 = split ? bi - 96 : bi, sstep = split ? 160 : nb;
  if (s0 >= 0)
    for (int it = s0; it < 256; it += sstep) s5_item(P, it, j);
}
__device__ __forceinline__ void scan_cd(const Params& P, int j) {
  for (int it = BID(); it < 128; it += gridDim.x) gdn_item2(P, it, j);
  for (int it = BID(); it < 256; it += gridDim.x)
    if (it >= 128) rwkv_item2(P, it - 128, j);
}

__device__ __forceinline__ void finish_ab(const Params& P, int j) {
  const int tid_ = TID(); const int lane = tid_ & 63, wave = tid_ >> 6;
  const u16* p = (const u16*)(wsp(P) + OFF_R);
  const u16* od0 = (const u16*)(wsp(P) + OFF_OUTDIR);
  const u16* od1 = od0 + (size_t)MROWS * DM;
  u16* mix = (u16*)(wsp(P) + OFF_XMOD);
  u16* zbuf = (u16*)(wsp(P) + OFF_ZBUF);
  const float* dsk = inp(P, I_S5D) + j * 256;
  const int stride = gridDim.x * 8;
  unsigned u0[8], u1[8], ux[8], n0[8], n1[8], nx[8];
  auto loadrow = [&](int row, unsigned* a0, unsigned* a1, unsigned* ax) {
    const u16* pr = p + (size_t)row * AB_NP;
#pragma unroll
    for (int seg = 0; seg < 8; ++seg) {
      const int c = seg * 128 + lane * 2;
      a0[seg] = *(const unsigned*)(od0 + (size_t)row * DM + c);
      a1[seg] = *(const unsigned*)(od1 + (size_t)row * DM + c);
      ax[seg] = *(const unsigned*)(pr + (seg < 2 ? c : c + 2304));
    }
  };
  int row = BID() * 8 + wave;
  if (row < MROWS) loadrow(row, u0, u1, ux);
  while (row < MROWS) {
    const int nrow = row + stride;
    if (nrow < MROWS) loadrow(nrow, n0, n1, nx);
#pragma unroll
    for (int seg = 0; seg < 8; ++seg) {
      const int c = seg * 128 + lane * 2;
      float a0 = lo16(u0[seg]) + lo16(u1[seg]), a1 = hi16(u0[seg]) + hi16(u1[seg]);
      if (seg < 2) {
        float y0 = a0 + dsk[c] * lo16(ux[seg]), y1 = a1 + dsk[c + 1] * hi16(ux[seg]);
        *(unsigned*)(zbuf + (size_t)row * 256 + c) = pack2(geluf_(y0), geluf_(y1));
      } else {
        float mu = wave_sum(a0 + a1) * (1.0f / 128.0f);
        float d0 = a0 - mu, d1 = a1 - mu;
        float var = wave_sum(d0 * d0 + d1 * d1) * (1.0f / 128.0f);
        float rs = rsqrtf(var + 1e-5f);
        *(unsigned*)(mix + (size_t)row * DM + c) = pack2(siluf_(lo16(ux[seg])) * d0 * rs, siluf_(hi16(ux[seg])) * d1 * rs);
      }
    }
#pragma unroll
    for (int seg = 0; seg < 8; ++seg) { u0[seg] = n0[seg]; u1[seg] = n1[seg]; ux[seg] = nx[seg]; }
    row = nrow;
  }
}

struct RowCD {
  unsigned u0[4], u1[4], uz[4];
  uint4 y0, y1, vc, vm, vn;
  unsigned gc, gm, gn, hc, hm, hn;
  float b0, b1;
};
__device__ __forceinline__ void finish_cd(const Params& P, int j) {
  extern __shared__ __attribute__((aligned(16))) char smem[];
  u16* sG = (u16*)smem;
  const int tid = TID(), lane = tid & 63, wave = tid >> 6;
  {
    const float* gup = inp(P, I_GUP) + (size_t)j * 96 * 512;
    for (int i = tid * 2; i < 96 * 512; i += NT * 2) *(unsigned*)(sG + i) = pack2(gup[i], gup[i + 1]);
  }
  __syncthreads();
  const u16* p = (const u16*)(wsp(P) + OFF_R);
  const u16* od0 = (const u16*)(wsp(P) + OFF_OUTDIR);
  const u16* od1 = od0 + (size_t)MROWS * DM;
  const float* bon0 = (const float*)(wsp(P) + OFF_BONUS);
  const float* bon1 = bon0 + (size_t)MROWS * 8;
  u16* mix = (u16*)(wsp(P) + OFF_XMOD);
  const float* mu = inp(P, I_MU) + (size_t)j * 1760;
  const float* gnw = inp(P, I_GNW) + j * 128;
  const float* lnw = inp(P, I_LNW) + j * 512;
  const float* lnb = inp(P, I_LNBB) + j * 512;
  constexpr int RB = 2064;
  const int ch = lane * 8, head = lane >> 3;
  const int stride = gridDim.x * 8;
  auto loadrow = [&](int row, RowCD& R_) {
    const u16* pr = p + (size_t)row * CD_NP;
#pragma unroll
    for (int seg = 0; seg < 4; ++seg) {
      const int c = seg * 128 + lane * 2;
      R_.u0[seg] = *(const unsigned*)(od0 + (size_t)row * DM + c);
      R_.u1[seg] = *(const unsigned*)(od1 + (size_t)row * DM + c);
      R_.uz[seg] = *(const unsigned*)(pr + 1536 + c);
    }
    int tt, L;
    if (row < MLAT) { tt = row & 4095; L = 4096; } else { tt = (row - MLAT) & 255; L = 256; }
    const bool hm_ = tt > 0, hn_ = tt < L - 1;
    const u16* pc = pr + RB;
    const u16* pm = hm_ ? pc - CD_NP : pc;
    const u16* pp = hn_ ? pc + CD_NP : pc;
    R_.y0 = *(const uint4*)(od0 + (size_t)row * DM + 512 + ch);
    R_.y1 = *(const uint4*)(od1 + (size_t)row * DM + 512 + ch);
    R_.vc = *(const uint4*)(pc + 1024 + ch);
    R_.vm = ldz4(pm + 1024 + ch, hm_);
    R_.vn = ldz4(pp + 1024 + ch, hn_);
    const int c1 = 1664 + lane, c2 = 1664 + 64 + (lane & 31);
    R_.gc = pc[c1]; R_.gm = hm_ ? (unsigned)pm[c1] : 0u; R_.gn = hn_ ? (unsigned)pp[c1] : 0u;
    R_.hc = pc[c2]; R_.hm = hm_ ? (unsigned)pm[c2] : 0u; R_.hn = hn_ ? (unsigned)pp[c2] : 0u;
    R_.b0 = bon0[(size_t)row * 8 + head]; R_.b1 = bon1[(size_t)row * 8 + head];
  };
  RowCD A_, N_;
  int row = BID() * 8 + wave;
  if (row < MROWS) loadrow(row, A_);
  while (row < MROWS) {
    const int nrow = row + stride;
    if (nrow < MROWS) loadrow(nrow, N_);
#pragma unroll
    for (int seg = 0; seg < 4; ++seg) {
      const int c = seg * 128 + lane * 2;
      float a0 = lo16(A_.u0[seg]) + lo16(A_.u1[seg]), a1 = hi16(A_.u0[seg]) + hi16(A_.u1[seg]);
      float ms = wave_sum(a0 * a0 + a1 * a1) * (1.0f / 128.0f);
      float rs = rsqrtf(ms + 1e-6f);
      *(unsigned*)(mix + (size_t)row * DM + c) =
          pack2(a0 * rs * gnw[lane * 2] * siluf_(lo16(A_.uz[seg])), a1 * rs * gnw[lane * 2 + 1] * siluf_(hi16(A_.uz[seg])));
    }
    float sg0, sg1;
    {
      float c = lo16(A_.gc), m = lo16(A_.gm), n = lo16(A_.gn);
      sg0 = sigmoidf_(c + mu[1664 + lane] * (0.5f * (m + n) - c));
      c = lo16(A_.hc); m = lo16(A_.hm); n = lo16(A_.hn);
      sg1 = sigmoidf_(c + mu[1664 + 64 + (lane & 31)] * (0.5f * (m + n) - c));
    }
    float g[8];
#pragma unroll
    for (int i = 0; i < 8; ++i) g[i] = 0.f;
#pragma unroll 8
    for (int l = 0; l < 64; ++l) {
      float s = __int_as_float(__builtin_amdgcn_readlane(__float_as_int(sg0), l));
      float w[8]; ld8(sG + l * 512 + ch, w);
#pragma unroll
      for (int i = 0; i < 8; ++i) g[i] += s * w[i];
    }
#pragma unroll 8
    for (int l = 0; l < 32; ++l) {
      float s = __int_as_float(__builtin_amdgcn_readlane(__float_as_int(sg1), l));
      float w[8]; ld8(sG + (64 + l) * 512 + ch, w);
#pragma unroll
      for (int i = 0; i < 8; ++i) g[i] += s * w[i];
    }
    float y[8], y1[8], v[8];
    unpack8(A_.y0, y); unpack8(A_.y1, y1);
    float s = 0.f;
#pragma unroll
    for (int i = 0; i < 8; ++i) { y[i] += y1[i]; s += y[i]; }
    float mean = reduce8(s) * (1.0f / 64.0f);
    float q = 0.f;
#pragma unroll
    for (int i = 0; i < 8; ++i) { y[i] -= mean; q += y[i] * y[i]; }
    float rs = rsqrtf(reduce8(q) * (1.0f / 64.0f) + 64e-5f);
    shiftmix8(A_.vc, A_.vm, A_.vn, mu + 1024 + ch, v);
    const float bon = A_.b0 + A_.b1;
    float o[8];
#pragma unroll
    for (int i = 0; i < 8; ++i) o[i] = (y[i] * rs * lnw[ch + i] + lnb[ch + i] + bon * v[i]) * g[i];
    uint4 u; u.x = pack2(o[0], o[1]); u.y = pack2(o[2], o[3]); u.z = pack2(o[4], o[5]); u.w = pack2(o[6], o[7]);
    *(uint4*)(mix + (size_t)row * DM + 512 + ch) = u;
    A_ = N_;
    row = nrow;
  }
}

#define XB_TMO      128
#define XB_XCNT(j)  (256  + 64 * (j))
#define XB_XSUB(j)  (1280 + 64 * (j))
#define XB_XGEN(j)  (2304 + 64 * (j))
#define XB_TOP      3328
#define XB_TOPGEN   3392
#define XCD_BAR_WORDS 3456
#define XB_SPIN_CAP (1u << 20)
#define LAS __attribute__((address_space(3)))
__device__ __forceinline__ unsigned xb_ld(unsigned* p)              { return __hip_atomic_load(p, __ATOMIC_RELAXED, __HIP_MEMORY_SCOPE_AGENT); }
__device__ __forceinline__ unsigned xb_add(unsigned* p, unsigned v) { return __hip_atomic_fetch_add(p, v, __ATOMIC_RELAXED, __HIP_MEMORY_SCOPE_AGENT); }
__device__ __forceinline__ unsigned xb_xcc_id() { return (unsigned)__builtin_amdgcn_s_getreg((3 << 11) | 20) & 0xFu; }
#define XB_SPIN(cond, bar) do { unsigned _sp = 0; while (cond) { __builtin_amdgcn_s_sleep(1); \
    if ((++_sp & 255u) == 0u) { if (xb_ld(&(bar)[XB_TMO])) break; if (_sp > XB_SPIN_CAP) { atomicAdd(&(bar)[XB_TMO], 1u); break; } } } } while (0)
struct XcdBarrier { unsigned* bar; unsigned x; volatile LAS unsigned* st; };
__device__ __forceinline__ XcdBarrier xcd_barrier_post(unsigned* bar, volatile LAS unsigned* st) {
    XcdBarrier b; b.bar = bar; b.x = xb_xcc_id(); b.st = st;
    if (threadIdx.x == 0) (void)xb_add(&bar[XB_XCNT(b.x)], 1u);
    return b;
}
__device__ __forceinline__ void xcd_barrier_complete(unsigned* bar, unsigned x, unsigned& nloc, unsigned& nx) {
    const unsigned G = gridDim.x * gridDim.y * gridDim.z;
    unsigned sum, cnt, mine, sp = 0u;
    for (;;) {
        sum = 0u; cnt = 0u; mine = 0u;
#pragma unroll
        for (unsigned j = 0; j < 16; ++j) { const unsigned c = xb_ld(&bar[XB_XCNT(j)]); sum += c; cnt += (c > 0u) ? 1u : 0u; mine = (j == x) ? c : mine; }
        if (sum == G) break;
        __builtin_amdgcn_s_sleep(1);
        if ((++sp & 255u) == 0u) { if (xb_ld(&bar[XB_TMO])) break; if (sp > XB_SPIN_CAP) { atomicAdd(&bar[XB_TMO], 1u); break; } }
    }
    nloc = mine > 0u ? mine : 1u; nx = cnt > 0u ? cnt : 1u;
}
__device__ __forceinline__ void xcd_barrier(const XcdBarrier& b) {
    asm volatile("s_waitcnt vmcnt(0)" ::: "memory");
    __syncthreads();
    if (threadIdx.x == 0) {
        unsigned* bar = b.bar;
        __builtin_amdgcn_s_waitcnt(0);
        unsigned nloc = b.st[0], nx = b.st[1];
        if (nloc == 0u) { xcd_barrier_complete(bar, b.x, nloc, nx); b.st[0] = nloc; b.st[1] = nx; }
        const unsigned old = xb_add(&bar[XB_XSUB(b.x)], 1u);
        const unsigned gen = old / nloc;
        if (old + 1u == (gen + 1u) * nloc) {
            __builtin_amdgcn_fence(__ATOMIC_RELEASE, "agent");
            asm volatile("s_waitcnt vmcnt(0)" ::: "memory");
            const unsigned og = xb_add(&bar[XB_TOP], 1u);
            const unsigned tg = og / nx;
            if (og + 1u == (tg + 1u) * nx) xb_add(&bar[XB_TOPGEN], 1u);
            else XB_SPIN(xb_ld(&bar[XB_TOPGEN]) == tg, bar);
            __builtin_amdgcn_fence(__ATOMIC_ACQUIRE, "agent");
            xb_add(&bar[XB_XGEN(b.x)], 1u);
            asm volatile("s_waitcnt vmcnt(0)" ::: "memory");
        } else {
            XB_SPIN(xb_ld(&bar[XB_XGEN(b.x)]) == gen, bar);
            __builtin_amdgcn_fence(__ATOMIC_ACQUIRE, "agent");
            asm volatile("s_waitcnt vmcnt(0)" ::: "memory");
        }
    }
    __syncthreads();
}

__global__ void __launch_bounds__(NT) mega(Params P) {
  cg::grid_group grid = cg::this_grid();
  __shared__ uint4 xb_words;
  if (threadIdx.x == 0) xb_words = make_uint4(0u, 0u, 0u, 0u);
  __syncthreads();
  const XcdBarrier xb = xcd_barrier_post((unsigned*)(P.ws + OFF_BAR), (volatile LAS unsigned*)&xb_words);
  float* mods = (float*)(wsp(P) + OFF_MODS);
  u16* xmod = (u16*)(wsp(P) + OFF_XMOD);
  u16* R = (u16*)(wsp(P) + OFF_R);
  for (int step = 0; step < 50; ++step) {
    int l = 0, kind = -1, cv = -1;
    if (step == 0) cv = 0;
    if (step >= 2) { l = (step - 2) / 12; kind = (step - 2) % 12; if (kind == 2 && l < 3) cv = l + 1; }
    const u16* wb = (const u16*)(wsp(P) + (size_t)(l & 1) * WB_SLOT);
    const float* ml = mods + (size_t)l * 9 * 9216;
    const int j = l >> 1;
    const bool ab = (l & 1) == 0;
    if (step == 0) {
      mods_phase(P);
      tables_phase(P);
    } else if (step == 1 || kind == 2 || kind == 8 || kind == 11) {
      const int sub = kind == 2 ? 0 : (kind == 8 ? 1 : 2);
      const float* lng = inp(P, I_LNG) + (size_t)(l * 3 + sub) * 1024;
      const float* lnb = inp(P, I_LNB) + (size_t)(l * 3 + sub) * 1024;
      const float* mn = step == 1 ? mods : (kind == 11 ? (l < 3 ? ml + 9 * 9216 : nullptr) : ml);
      const int js = (step == 1 || kind == 11) ? 0 : (kind == 2 ? 3 : 6);
      const bool lastpost = (l == 3) && (kind == 8 || kind == 11);
      rowpass(P, step == 1, lng, lnb, mn, js, js + 1, lastpost ? MLAT : MROWS, step != 1 && !lastpost);
    } else if (kind == 0 || kind == 9) {
      EpiArgs e{}; e.outbf = R; e.ld = DFF;
      e.nm = (l == 3 && kind == 9) ? 128 : 0;
      for (int rep = 0; rep < ((PROBE_MASK & 4) ? 2 : 1); ++rep)
        gemm_phase<EPI_ACT>(P, xmod, wb + (kind == 0 ? WFI0 : WFI1), 5632, 1024, e);
    } else if (kind == 1 || kind == 7 || kind == 10) {
      EpiArgs e{};
      e.gate = ml + (kind == 1 ? 2 : (kind == 7 ? 5 : 8)) * 1024;
      e.sc = kind == 7 ? 1.0f : 0.5f;
      const u16* A = kind == 7 ? xmod : R;
      const u16* B = wb + (kind == 1 ? WFO0 : (kind == 7 ? WMO : WFO1));
      {
        const int pl = kind == 1 ? l - 1 : l, psub = kind == 1 ? 2 : (kind == 7 ? 0 : 1);
        if (pl >= 0) { e.plng = inp(P, I_LNG) + (size_t)(pl * 3 + psub) * 1024; e.plnb = inp(P, I_LNB) + (size_t)(pl * 3 + psub) * 1024; }
        else e.hsrc = inp(P, I_X);
      }
      e.nm = 128;
      e.split = !((l == 3) && kind != 1);
      gemm_phase<EPI_RES>(P, A, B, 1024, kind == 7 ? 1024 : DFF, e);
    } else if (kind == 3) {
      EpiArgs e{}; e.outbf = R; e.ld = ab ? AB_NP : CD_NP;
      gemm_phase<EPI_PBF>(P, xmod, wb + WMI, ab ? AB_NP : CD_NP, 1024, e);
    } else if (kind == 4) {
      for (int rep = 0; rep < ((ab ? (PROBE_MASK & 1) : (PROBE_MASK & 2)) ? 2 : 1); ++rep) {
        if (ab) scan_ab(P, j); else scan_cd(P, j);
      }
    } else if (kind == 5) {
      if (ab) finish_ab(P, j); else finish_cd(P, j);
    } else if (kind == 6) {
      if (!ab) continue;
      EpiArgs e{}; e.outbf = xmod; e.ld = DM; e.zbuf = (const u16*)(wsp(P) + OFF_ZBUF); e.glub = inp(P, I_GLUB) + j * 256;
      gemm_phase<EPI_GLU>(P, (const u16*)(wsp(P) + OFF_ZBUF), wb + WGLU, 256, 256, e);
    }
    if (cv >= 0) convert_layer(P, cv);
    if (gridDim.x == 0x7fffffffu) grid.sync();
    xcd_barrier(xb);
  }
}

extern "C" void kernel_launch(void* const* d_in, const int* in_sizes, int n_in, void* d_out,
                              int out_size, void* d_ws, size_t ws_size, hipStream_t stream) {
  static int grid_blocks = 0;
  if (!grid_blocks) {
    int dev = 0, cus = 0, per_cu = 0;
    (void)hipGetDevice(&dev);
    (void)hipDeviceGetAttribute(&cus, hipDeviceAttributeMultiprocessorCount, dev);
    (void)hipFuncSetAttribute((const void*)mega, hipFuncAttributeMaxDynamicSharedMemorySize, LDS_BYTES);
    (void)hipOccupancyMaxActiveBlocksPerMultiprocessor(&per_cu, (const void*)mega, NT, LDS_BYTES);
    if (per_cu < 1) fprintf(stderr, "occupancy query says %d blocks/CU\n", per_cu);
    grid_blocks = cus;
    if (ws_size < WS_END) fprintf(stderr, "workspace too small: %zu < %zu\n", ws_size, (size_t)WS_END);
  }
  Params p{};
  for (int i = 0; i < 40; ++i) p.in[i] = (const float*)d_in[i];
  p.out = (float*)d_out;
  p.ws = (char*)d_ws;
  void* args[] = {&p};
  (void)hipMemsetAsync((char*)d_ws + OFF_BAR, 0, 16384, stream);
  hipError_t e = hipLaunchCooperativeKernel((void*)mega, dim3(grid_blocks), dim3(NT), args, LDS_BYTES, stream);
  if (e != hipSuccess) fprintf(stderr, "cooperative launch failed: %s (grid %d)\n", hipGetErrorString(e), grid_blocks);
}
```

```cpp
#include <hip/hip_runtime.h>
#include <hip/hip_bf16.h>
#include <hip/hip_cooperative_groups.h>
#include <cstdio>
namespace cg = cooperative_groups;

typedef unsigned short u16;
using bf16x8 = __attribute__((ext_vector_type(8))) short;
using f32x4 = __attribute__((ext_vector_type(4))) float;

#ifndef PROBE_MASK
#define PROBE_MASK 0
#endif
constexpr int NT = 512;
constexpr int LDS_BYTES = 155648;
constexpr int MLAT = 32768, MCTX = 2048, MROWS = 34816, DM = 1024, DFF = 2816;
constexpr int AB_NP = 3328, CD_NP = 3840, CD_IN_V = 3824;
constexpr float ALPHA = 1.681792830507429f;

enum { I_X = 0, I_C, I_CTX, I_CCTX, I_ADAW, I_ADAB, I_FFI, I_FFO, I_LNG, I_LNB, I_ABWI, I_ABWO, I_LAMRE, I_LAMIM,
       I_LOGDT, I_BRE, I_BIM, I_CRE, I_CIM, I_S5D, I_GLUW, I_GLUB, I_RETLR, I_CDWI, I_CDWO, I_CONVW, I_ALOG,
       I_DTB, I_GNW, I_MU, I_W0, I_WUP, I_A0, I_AUP, I_GUP, I_KK, I_KA, I_RK, I_LNW, I_LNBB };

constexpr size_t WB_SLOT = 50331648;
constexpr size_t OFF_HCTX = 2 * WB_SLOT;
constexpr size_t OFF_XMOD = OFF_HCTX + 8388608;
constexpr size_t OFF_R = OFF_XMOD + 71303168;
constexpr size_t OFF_OUTDIR = OFF_R + 267386880;
constexpr size_t OFF_ZBUF = OFF_OUTDIR + 142606336;
constexpr size_t OFF_MODS = OFF_ZBUF + 17825792;
constexpr size_t OFF_ROPE = OFF_MODS + 1327104;
constexpr size_t OFF_S5TAB = OFF_ROPE + 16384;
constexpr size_t OFF_BONUS = OFF_S5TAB + 557056;
constexpr size_t OFF_BAR = OFF_BONUS + 2228224;
constexpr size_t OFF_PART = OFF_BAR + 16384;
constexpr size_t OFF_RSTAT = OFF_PART + 16777216;
constexpr size_t WS_END = OFF_RSTAT + 262144;
constexpr size_t WFI0 = 0, WFI1 = 5767168, WFO0 = 11534336, WFO1 = 14417920, WMI = 17301504, WMO = 21233664, WGLU = 22282240;

struct Params {
  const float* in[40];
  float* out;
  char* ws;
};


__device__ __forceinline__ long zoff() { int z = 0; asm volatile("" : "+s"(z)); return (long)z; }
__device__ __forceinline__ const float* inp(const Params& P, int i) { return P.in[i] + zoff(); }
__device__ __forceinline__ char* wsp(const Params& P) { return P.ws + zoff(); }
__device__ __forceinline__ float* outp(const Params& P) { return P.out + zoff(); }
__device__ __forceinline__ int TID() { int t = threadIdx.x; asm volatile("" : "+v"(t)); return t; }
__device__ __forceinline__ int BID() { int b = blockIdx.x; asm volatile("" : "+s"(b)); return b; }

__device__ __forceinline__ float bf2f(u16 u) { return __uint_as_float(((unsigned)u) << 16); }
typedef __bf16 bf16x2_hw __attribute__((ext_vector_type(2)));
typedef float f32x2_hw __attribute__((ext_vector_type(2)));
__device__ __forceinline__ u16 f2bf(float f) { return __builtin_bit_cast(u16, (__bf16)f); }
__device__ __forceinline__ unsigned pack2(float a, float b) {
  f32x2_hw v = {a, b};
  return __builtin_bit_cast(unsigned, __builtin_convertvector(v, bf16x2_hw));
}
__device__ __forceinline__ float lo16(unsigned u) { return __uint_as_float(u << 16); }
__device__ __forceinline__ float hi16(unsigned u) { return __uint_as_float(u & 0xffff0000u); }
__device__ __forceinline__ float sigmoidf_(float x) { return __builtin_amdgcn_rcpf(1.0f + __expf(-x)); }
__device__ __forceinline__ float siluf_(float x) { return x * __builtin_amdgcn_rcpf(1.0f + __expf(-x)); }
__device__ __forceinline__ float softplusf_(float x) { return fmaxf(x, 0.0f) + log1pf(__expf(-fabsf(x))); }
__device__ __forceinline__ float geluf_(float x) {
  float u = 0.7978845608028654f * (x + 0.044715f * x * x * x);
  return x * __builtin_amdgcn_rcpf(1.0f + __expf(-2.0f * u));
}
template <int CTRL>
__device__ __forceinline__ float dpp_add(float x) {
  int v = __builtin_amdgcn_update_dpp(0, __float_as_int(x), CTRL, 0xf, 0xf, true);
  return x + __int_as_float(v);
}
__device__ __forceinline__ float reduce16(float x) {
  x = dpp_add<0xB1>(x);
  x = dpp_add<0x4E>(x);
  x = dpp_add<0x141>(x);
  x = dpp_add<0x140>(x);
  return x;
}
__device__ __forceinline__ float reduce8(float x) {
  x = dpp_add<0xB1>(x);
  x = dpp_add<0x4E>(x);
  x = dpp_add<0x141>(x);
  return x;
}
__device__ __forceinline__ float wave_sum(float x) {
  x = reduce16(x);
  const int xi = __float_as_int(x);
  return (__int_as_float(__builtin_amdgcn_readlane(xi, 0)) + __int_as_float(__builtin_amdgcn_readlane(xi, 16))) +
         (__int_as_float(__builtin_amdgcn_readlane(xi, 32)) + __int_as_float(__builtin_amdgcn_readlane(xi, 48)));
}
__device__ __forceinline__ float* hrow(const Params& P, int row) {
  return row < MLAT ? outp(P) + (size_t)row * DM : (float*)(wsp(P) + OFF_HCTX) + (size_t)(row - MLAT) * DM;
}

__device__ __forceinline__ void mods_phase(const Params& P) {
  extern __shared__ __attribute__((aligned(16))) char smem[];
  float* s = (float*)smem;
  float* red = s + 9 * 1024;
  const int tid = TID();
  for (int i = tid; i < 9 * 1024; i += NT) {
    int who = i >> 10, k = i & 1023;
    float v = who < 8 ? inp(P, I_C)[who * 1024 + k] : inp(P, I_CCTX)[k];
    s[i] = v / (1.0f + expf(-v));
  }
  __syncthreads();
  float* mods = (float*)(wsp(P) + OFF_MODS);
  const float* adaw = inp(P, I_ADAW);
  const float* adab = inp(P, I_ADAB);
  for (int item = BID(); item < 576; item += gridDim.x) {
    int l = item / 144, n0 = (item % 144) * 64;
    int n4 = tid & 15, ks = tid >> 4;
    float acc[9][4];
#pragma unroll
    for (int w = 0; w < 9; ++w) { acc[w][0] = 0.f; acc[w][1] = 0.f; acc[w][2] = 0.f; acc[w][3] = 0.f; }
    const float* wp = adaw + ((size_t)l * 1024 + ks * 32) * 9216 + n0 + n4 * 4;
#pragma unroll 4
    for (int kk = 0; kk < 32; ++kk) {
      float4 w = *(const float4*)(wp + (size_t)kk * 9216);
      int k = ks * 32 + kk;
#pragma unroll
      for (int who = 0; who < 9; ++who) {
        float sv = s[who * 1024 + k];
        acc[who][0] += sv * w.x; acc[who][1] += sv * w.y; acc[who][2] += sv * w.z; acc[who][3] += sv * w.w;
      }
    }
#pragma unroll
    for (int who = 0; who < 9; ++who) {
      float4 v; v.x = acc[who][0]; v.y = acc[who][1]; v.z = acc[who][2]; v.w = acc[who][3];
      *(float4*)(red + (ks * 9 + who) * 64 + n4 * 4) = v;
    }
    __syncthreads();
    for (int o = tid; o < 576; o += NT) {
      int who = o >> 6, n = o & 63;
      float sum = adab[l * 9216 + n0 + n];
      for (int q = 0; q < 32; ++q) sum += red[(q * 9 + who) * 64 + n];
      mods[(size_t)(l * 9 + who) * 9216 + n0 + n] = sum;
    }
    __syncthreads();
  }
}

__device__ __forceinline__ void tables_phase(const Params& P) {
  const int gt = BID() * NT + TID(), gs = gridDim.x * NT;
  float* rope = (float*)(wsp(P) + OFF_ROPE);
  for (int i = gt; i < 2048; i += gs) {
    int pos = i >> 5, f = i & 31;
    float freq = powf(10000.0f, -(float)f / 32.0f);
    float ang = (float)pos * freq;
    rope[i * 2] = cosf(ang);
    rope[i * 2 + 1] = sinf(ang);
  }
  float* tab = (float*)(wsp(P) + OFF_S5TAB);
  for (int i = gt; i < 4096; i += gs) {
    int p = i & 63, g = (i >> 6) & 15, jd = i >> 10;
    int j = jd >> 1;
    float lre = inp(P, I_LAMRE)[(jd * 16 + g) * 64 + p];
    float lim = inp(P, I_LAMIM)[(jd * 16 + g) * 64 + p];
    float dt = expf(inp(P, I_LOGDT)[jd * 16 + g]);
    float mag = expf(lre * dt), ang = lim * dt;
    float lbr = mag * cosf(ang), lbi = mag * sinf(ang);
    float den = lre * lre + lim * lim;
    float nr = lbr - 1.0f;
    float cre = (nr * lre + lbi * lim) / den;
    float cim = (lbi * lre - nr * lim) / den;
    float* t = tab + (size_t)jd * 34816;
    t[g * 64 + p] = lbr;
    t[1024 + g * 64 + p] = lbi;
    const float* bre = inp(P, I_BRE) + ((size_t)(j * 16 + g) * 64 + p) * 16;
    const float* bim = inp(P, I_BIM) + ((size_t)(j * 16 + g) * 64 + p) * 16;
    for (int c = 0; c < 16; ++c) {
      float br = bre[c], bi = bim[c];
      t[2048 + (g * 64 + p) * 16 + c] = cre * br - cim * bi;
      t[2048 + 16384 + (g * 64 + p) * 16 + c] = cre * bi + cim * br;
    }
  }
}

__device__ __forceinline__ void conv_mat(const float* __restrict__ src, int K, int Nsrc, int Npad, bool perm, u16* __restrict__ dst, int rot) {
  extern __shared__ __attribute__((aligned(16))) char smem[];
  float* tile = (float*)smem;
  const int tid = TID();
  const int nk = K / 64, ntiles = nk * (Npad / 64);
  int start = (BID() + gridDim.x - (rot % gridDim.x)) % gridDim.x;
  for (int t = start; t < ntiles; t += gridDim.x) {
    int kt = t % nk, ntile = t / nk;
    int k0 = kt * 64, n0 = ntile * 64;
    {
      int r = tid >> 6, c = tid & 63;
      int np = n0 + c;
      int col = np;
      if (perm) { int blk = np >> 5, w = np & 31; int jj = blk * 16 + (w & 15); col = (w < 16) ? jj : DFF + jj; }
      bool ok = np < Nsrc;
#pragma unroll
      for (int i = 0; i < 8; ++i) {
        int k = k0 + r + 8 * i;
        tile[(r + 8 * i) * 65 + c] = ok ? src[(size_t)k * Nsrc + col] : 0.0f;
      }
    }
    __syncthreads();
    {
      int nn = tid >> 3, kg = tid & 7;
      uint4 o;
      o.x = pack2(tile[(kg * 8 + 0) * 65 + nn], tile[(kg * 8 + 1) * 65 + nn]);
      o.y = pack2(tile[(kg * 8 + 2) * 65 + nn], tile[(kg * 8 + 3) * 65 + nn]);
      o.z = pack2(tile[(kg * 8 + 4) * 65 + nn], tile[(kg * 8 + 5) * 65 + nn]);
      o.w = pack2(tile[(kg * 8 + 6) * 65 + nn], tile[(kg * 8 + 7) * 65 + nn]);
      *(uint4*)(dst + (size_t)(n0 + nn) * K + k0 + kg * 8) = o;
    }
    __syncthreads();
  }
}

__device__ __forceinline__ void convert_layer(const Params& P, int l) {
  u16* wb = (u16*)(wsp(P) + (size_t)(l & 1) * WB_SLOT);
  const int j = l >> 1;
  const bool ab = (l & 1) == 0;
  for (int m = 0; m < 7; ++m) {
    const float* src; int K, Nsrc, Npad, rot; bool perm = false; u16* dst;
    if (m < 2) { src = inp(P, I_FFI) + (size_t)(l * 2 + m) * 1024 * 5632; K = 1024; Nsrc = 5632; Npad = 5632; perm = true; dst = wb + (m ? WFI1 : WFI0); rot = m * 128; }
    else if (m < 4) { src = inp(P, I_FFO) + (size_t)(l * 2 + (m - 2)) * 2816 * 1024; K = 2816; Nsrc = 1024; Npad = 1024; dst = wb + (m == 3 ? WFO1 : WFO0); rot = (m - 2) * 192; }
    else if (m == 4) {
      if (ab) { src = inp(P, I_ABWI) + (size_t)j * 1024 * AB_NP; Nsrc = AB_NP; Npad = AB_NP; }
      else { src = inp(P, I_CDWI) + (size_t)j * 1024 * CD_IN_V; Nsrc = CD_IN_V; Npad = CD_NP; }
      K = 1024; dst = wb + WMI; rot = 128;
    }
    else if (m == 5) { src = (ab ? inp(P, I_ABWO) : inp(P, I_CDWO)) + (size_t)j * 1024 * 1024; K = 1024; Nsrc = 1024; Npad = 1024; dst = wb + WMO; rot = 64; }
    else { if (!ab) continue; src = inp(P, I_GLUW) + (size_t)j * 65536; K = 256; Nsrc = 256; Npad = 256; dst = wb + WGLU; rot = 32; }
    conv_mat(src, K, Nsrc, Npad, perm, dst, rot);
  }
}

__device__ __forceinline__ void rowpass(const Params& P, bool init, const float* lng, const float* lnb, const float* modsNext, int js, int jc, int nrows, bool parts) {
  const int tid_ = TID(); const int lane = tid_ & 63, wave = tid_ >> 6;
  u16* xmod = (u16*)(wsp(P) + OFF_XMOD);
  const int stride = gridDim.x * 8;
  float4 g4[4], b4[4];
#pragma unroll
  for (int i = 0; i < 4; ++i) { g4[i] = make_float4(1.f, 1.f, 1.f, 1.f); b4[i] = make_float4(0.f, 0.f, 0.f, 0.f); }
  if (!init) {
#pragma unroll
    for (int i = 0; i < 4; ++i) { g4[i] = *(const float4*)(lng + i * 256 + lane * 4); b4[i] = *(const float4*)(lnb + i * 256 + lane * 4); }
  }
  auto srcrow = [&](int row) -> const float* {
    return init ? (row < MLAT ? inp(P, I_X) + (size_t)row * DM : inp(P, I_CTX) + (size_t)(row - MLAT) * DM) : hrow(P, row);
  };
  int row = BID() * 8 + wave;
  float4 v[4], vn[4];
  if (row < nrows) {
    const float* src = srcrow(row);
#pragma unroll
    for (int i = 0; i < 4; ++i) v[i] = *(const float4*)(src + i * 256 + lane * 4);
  }
  while (row < nrows) {
    const int nrow = row + stride;
    if (nrow < nrows) {
      const float* src = srcrow(nrow);
#pragma unroll
      for (int i = 0; i < 4; ++i) vn[i] = *(const float4*)(src + i * 256 + lane * 4);
    }
    const int who = row < MLAT ? (row >> 12) : 8;
    float4 sa[4], sc4[4];
    if (modsNext) {
      const float* sh = modsNext + (size_t)who * 9216 + js * 1024;
      const float* sc = modsNext + (size_t)who * 9216 + jc * 1024;
#pragma unroll
      for (int i = 0; i < 4; ++i) { sa[i] = *(const float4*)(sh + i * 256 + lane * 4); sc4[i] = *(const float4*)(sc + i * 256 + lane * 4); }
    }
    float* dst = hrow(P, row);
    if (parts && row >= MLAT) {
      const float* p0 = (const float*)(wsp(P) + OFF_PART) + (size_t)(row - MLAT) * DM;
      const float* p1 = p0 + (size_t)MCTX * DM;
#pragma unroll
      for (int i = 0; i < 4; ++i) {
        const float4 a = *(const float4*)(p0 + i * 256 + lane * 4), c = *(const float4*)(p1 + i * 256 + lane * 4);
        v[i].x = ALPHA * v[i].x + (a.x + c.x); v[i].y = ALPHA * v[i].y + (a.y + c.y);
        v[i].z = ALPHA * v[i].z + (a.z + c.z); v[i].w = ALPHA * v[i].w + (a.w + c.w);
      }
    }
    if (!init) {
      float s = 0.f;
#pragma unroll
      for (int i = 0; i < 4; ++i) s += v[i].x + v[i].y + v[i].z + v[i].w;
      s = wave_sum(s);
      float mu = s * (1.0f / 1024.0f);
      float q = 0.f;
#pragma unroll
      for (int i = 0; i < 4; ++i) {
        float a = v[i].x - mu, b = v[i].y - mu, c = v[i].z - mu, d = v[i].w - mu;
        q += a * a + b * b + c * c + d * d;
      }
      q = wave_sum(q);
      float rstd = rsqrtf(q * (1.0f / 1024.0f) + 1e-5f);
      if (row < MLAT && lane == 0) *(float2*)((float*)(wsp(P) + OFF_RSTAT) + (size_t)row * 2) = make_float2(mu, rstd);
#pragma unroll
      for (int i = 0; i < 4; ++i) {
        v[i].x = (v[i].x - mu) * rstd * g4[i].x + b4[i].x;
        v[i].y = (v[i].y - mu) * rstd * g4[i].y + b4[i].y;
        v[i].z = (v[i].z - mu) * rstd * g4[i].z + b4[i].z;
        v[i].w = (v[i].w - mu) * rstd * g4[i].w + b4[i].w;
      }
    }
    if (row >= MLAT || !modsNext) {
#pragma unroll
      for (int i = 0; i < 4; ++i) *(float4*)(dst + i * 256 + lane * 4) = v[i];
    }
    if (modsNext) {
#pragma unroll
      for (int i = 0; i < 4; ++i) {
        uint2 o;
        o.x = pack2(v[i].x * (1.0f + sc4[i].x) + sa[i].x, v[i].y * (1.0f + sc4[i].y) + sa[i].y);
        o.y = pack2(v[i].z * (1.0f + sc4[i].z) + sa[i].z, v[i].w * (1.0f + sc4[i].w) + sa[i].w);
        *(uint2*)(xmod + (size_t)row * DM + i * 256 + lane * 4) = o;
      }
    }
#pragma unroll
    for (int i = 0; i < 4; ++i) v[i] = vn[i];
    row = nrow;
  }
}

constexpr int GBK = 64, GHALF = 128, GHT = GHALF * GBK;
__device__ __forceinline__ int lds_byte(int r, int c) {
  int st = (r >> 4) * 2 + (c >> 5), rr = r & 15, cc = c & 31, ob = rr * 64 + cc * 2;
  return st * 1024 + (ob ^ (((ob >> 9) & 1) << 5));
}
__device__ __forceinline__ void stage_rc(int b, int& R, int& C) {
  int st = b / 1024, sb = b % 1024, swz = sb ^ (((sb >> 9) & 1) << 5);
  R = (st >> 1) * 16 + swz / 64; C = (st & 1) * 32 + (swz % 64) / 2;
}
enum { EPI_ACT = 0, EPI_RES = 1, EPI_PBF = 2, EPI_GLU = 3 };
struct EpiArgs {
  u16* outbf; int ld;
  const float* gate; float sc;
  const u16* zbuf; const float* glub;
  int nm;
  int split;
  const float* plng; const float* plnb;
  const float* hsrc;
};

template <int MODE>
__device__ __forceinline__ void gemm_phase(const Params& P, const u16* __restrict__ A, const u16* __restrict__ Bt, int N, int K, EpiArgs e) {
  extern __shared__ __attribute__((aligned(16))) char smem[];
  u16* shm = (u16*)smem;
#define SA(b, h) (shm + ((b) * 4 + (h)) * GHT)
#define SB(b, h) (shm + ((b) * 4 + 2 + (h)) * GHT)
#define STAGE(Pp, BASE, br, kt) do { unsigned long long _g = (unsigned long long)(BASE + (long)(br) * K + (long)(kt) * GBK); \
    unsigned _lo = __builtin_amdgcn_readfirstlane((unsigned)_g), _hi = __builtin_amdgcn_readfirstlane((unsigned)(_g >> 32)); \
    const char* _sp = (const char*)(((unsigned long long)_hi << 32) | _lo); \
    __builtin_amdgcn_global_load_lds((const unsigned*)(_sp + so0), (__attribute__((address_space(3))) unsigned*)((char*)(Pp) + lo0s), 16, 0, 0); \
    __builtin_amdgcn_global_load_lds((const unsigned*)(_sp + (size_t)128 * K + so0), (__attribute__((address_space(3))) unsigned*)((char*)(Pp) + lo0s + 8192), 16, 0, 0); } while (0)
#define LDA(dst, b, h) _Pragma("unroll") for (int m = 0; m < 4; ++m) _Pragma("unroll") for (int k = 0; k < 2; ++k) \
    dst[m][k] = *reinterpret_cast<const bf16x8*>((char*)SA(b, h) + a_off + m * 2048 + k * 1024)
#define LDB(dst, b, h) _Pragma("unroll") for (int n = 0; n < 2; ++n) _Pragma("unroll") for (int k = 0; k < 2; ++k) \
    dst[n][k] = *reinterpret_cast<const bf16x8*>((char*)SB(b, h) + b_off + n * 2048 + k * 1024)
#define MMA(ai, bj, At_, Bt_) do { __builtin_amdgcn_s_setprio(1); \
    _Pragma("unroll") for (int m = 0; m < 4; ++m) _Pragma("unroll") for (int n = 0; n < 2; ++n) _Pragma("unroll") for (int k = 0; k < 2; ++k) \
      acc[ai][bj][m][n] = __builtin_amdgcn_mfma_f32_16x16x32_bf16(At_[m][k], Bt_[n][k], acc[ai][bj][m][n], 0, 0, 0); \
    __builtin_amdgcn_s_setprio(0); } while (0)
#define WAIT_V(n) asm volatile("s_waitcnt vmcnt(" #n ")" ::: "memory")
#define WAIT_L(n) asm volatile("s_waitcnt lgkmcnt(" #n ")" ::: "memory")
#define BAR __builtin_amdgcn_s_barrier()
#define SCHED __builtin_amdgcn_sched_barrier(0)
  const int nN = N / 256, nM = e.nm ? e.nm : MROWS / 256, ntiles = nM * nN;
  const int nwork = ntiles + (e.split ? 2 * 8 * nN : 0);
  const int tid = TID();
  const int wid = __builtin_amdgcn_readfirstlane(tid >> 6);
  const int lane = tid & 63, wr = wid >> 2, wc = wid & 3, fr = lane & 15, fq = lane >> 4;
  const int lo0s = wid * 1024;
  unsigned so0;
  { int r, c; stage_rc(tid * 16, r, c); so0 = (unsigned)(r * K + c) * 2u; }
  const int a_off = lds_byte(wr * 64 + fr, fq * 8), b_off = lds_byte(wc * 32 + fr, fq * 8);
  const int bid = BID();
  const int nb = gridDim.x;
  const int slot = (nb % 8 == 0) ? (bid % 8) * (nb / 8) + bid / 8 : bid;
  auto decode = [&](int W, bool& part, int& ksel, int& nt, int& brow, int& bcol, const u16*& A_, const u16*& Bt_) {
    part = W >= ntiles;
    const int T = part ? ntiles + ((W - ntiles) >> 1) : W;
    ksel = part ? ((W - ntiles) & 1) : 0;
    nt = part ? K / (2 * GBK) : K / GBK;
    const int nMt = part ? nM + 8 : nM;
    const int nig = 8 * nN, gid = T / nig, fm = gid * 8, gsz = min(nMt - fm, 8);
    const int pm = fm + ((T % nig) % gsz), pn = (T % nig) / gsz;
    brow = pm * 256; bcol = pn * 256;
    A_ = A + (part ? ksel * (K / 2) : 0);
    Bt_ = Bt + (part ? ksel * (K / 2) : 0);
  };
  constexpr int EPI_OFF = 86016;
  if (slot < nwork) {
    bool part; int ksel, nt, brow, bcol; const u16* A_; const u16* Bt_;
    decode(slot, part, ksel, nt, brow, bcol, A_, Bt_);
    STAGE(SB(0, 0), Bt_, bcol, 0); STAGE(SA(0, 0), A_, brow, 0);
    STAGE(SB(0, 1), Bt_, bcol + GHALF, 0); STAGE(SA(0, 1), A_, brow + GHALF, 0);
  }
  for (int W = slot; W < nwork; W += nb) {
    bool part; int ksel, nt, brow, bcol; const u16* A_; const u16* Bt_;
    decode(W, part, ksel, nt, brow, bcol, A_, Bt_);
    f32x4 acc[2][2][4][2];
#pragma unroll
    for (int a = 0; a < 2; ++a)
#pragma unroll
      for (int b = 0; b < 2; ++b)
#pragma unroll
        for (int m = 0; m < 4; ++m)
#pragma unroll
          for (int n = 0; n < 2; ++n) acc[a][b][m][n] = (f32x4){0.f, 0.f, 0.f, 0.f};
    bf16x8 At[4][2], B0[2][2], B1[2][2];
    if (wr == 1) BAR;
    WAIT_V(4); BAR;
    STAGE(SB(1, 0), Bt_, bcol, 1); STAGE(SA(1, 0), A_, brow, 1); STAGE(SB(1, 1), Bt_, bcol + GHALF, 1);
    WAIT_V(6); BAR;
    for (int t = 0; t < nt - 2; t += 2) {
      LDB(B0, 0, 0); SCHED; LDA(At, 0, 0); STAGE(SA(1, 1), A_, brow + GHALF, t + 1);
      WAIT_L(8); BAR; WAIT_L(0); MMA(0, 0, At, B0); BAR; SCHED;
      LDB(B1, 0, 1); STAGE(SB(0, 0), Bt_, bcol, t + 2);
      BAR; WAIT_L(0); MMA(0, 1, At, B1); BAR;
      LDA(At, 0, 1); STAGE(SA(0, 0), A_, brow, t + 2);
      BAR; WAIT_L(0); MMA(1, 0, At, B0); BAR; SCHED;
      STAGE(SB(0, 1), Bt_, bcol + GHALF, t + 2);
      WAIT_V(6); BAR; MMA(1, 1, At, B1); BAR;
      LDB(B0, 1, 0); SCHED; LDA(At, 1, 0); STAGE(SA(0, 1), A_, brow + GHALF, t + 2);
      WAIT_L(8); BAR; WAIT_L(0); MMA(0, 0, At, B0); BAR; SCHED;
      LDB(B1, 1, 1); STAGE(SB(1, 0), Bt_, bcol, t + 3);
      BAR; WAIT_L(0); MMA(0, 1, At, B1); BAR;
      LDA(At, 1, 1); STAGE(SA(1, 0), A_, brow, t + 3);
      BAR; WAIT_L(0); MMA(1, 0, At, B0); BAR; SCHED;
      STAGE(SB(1, 1), Bt_, bcol + GHALF, t + 3);
      WAIT_V(6); BAR; MMA(1, 1, At, B1); BAR;
    }
    { LDB(B0, 0, 0); LDA(At, 0, 0); STAGE(SA(1, 1), A_, brow + GHALF, nt - 1);
      BAR; WAIT_L(0); MMA(0, 0, At, B0); BAR;
      LDB(B1, 0, 1); BAR; WAIT_L(0); MMA(0, 1, At, B1); BAR;
      LDA(At, 0, 1); WAIT_V(4); BAR; WAIT_L(0); MMA(1, 0, At, B0); MMA(1, 1, At, B1); BAR; }
    { LDB(B0, 1, 0); LDA(At, 1, 0); WAIT_V(2); BAR; WAIT_L(0); MMA(0, 0, At, B0); BAR;
      LDB(B1, 1, 1); WAIT_V(0); BAR; WAIT_L(0); MMA(0, 1, At, B1); BAR;
      LDA(At, 1, 1); BAR; WAIT_L(0); MMA(1, 0, At, B0); MMA(1, 1, At, B1); BAR; }
    if (wr == 0) BAR;
    const int who = brow < MLAT ? (brow >> 12) : 8;
    const int lane_e = TID() & 63;
    int fr_e = lane_e & 15, fq_e = lane_e >> 4;
    asm volatile("" : "+v"(fr_e), "+v"(fq_e));
    auto prefetch_next = [&]() {
      if (W + nb < nwork) {
        bool part2; int ksel2, nt2, brow2, bcol2; const u16* A2; const u16* Bt2;
        decode(W + nb, part2, ksel2, nt2, brow2, bcol2, A2, Bt2);
        STAGE(SB(0, 0), Bt2, bcol2, 0); STAGE(SA(0, 0), A2, brow2, 0);
        STAGE(SB(0, 1), Bt2, bcol2 + GHALF, 0); STAGE(SA(0, 1), A2, brow2 + GHALF, 0);
      }
    };
    if (MODE == EPI_RES) {
      constexpr int LDW = 260;
      float* st = (float*)(smem + EPI_OFF);
      int tq = TID();
      const int c4 = (tq & 63) * 4, r0 = tq >> 6;
      float4 g4 = *(const float4*)(e.gate + (size_t)who * 9216 + bcol + c4);
      g4.x *= e.sc; g4.y *= e.sc; g4.z *= e.sc; g4.w *= e.sc;
      float4 lg4 = make_float4(1.f, 1.f, 1.f, 1.f), lb4 = make_float4(0.f, 0.f, 0.f, 0.f);
      if (e.plng) { lg4 = *(const float4*)(e.plng + bcol + c4); lb4 = *(const float4*)(e.plnb + bcol + c4); }
#pragma unroll
      for (int ai = 0; ai < 2; ++ai) {
#pragma unroll
        for (int wq = 0; wq < 2; ++wq) {
          if (wr == wq) {
#pragma unroll
            for (int bj = 0; bj < 2; ++bj)
#pragma unroll
              for (int m = 0; m < 4; ++m)
#pragma unroll
                for (int n = 0; n < 2; ++n)
#pragma unroll
                  for (int jj = 0; jj < 4; ++jj)
                    st[(m * 16 + fq_e * 4 + jj) * LDW + bj * GHALF + wc * 32 + n * 16 + fr_e] = acc[ai][bj][m][n][jj];
          }
          if (ai == 1 && wq == 1) prefetch_next();
          WAIT_L(0); BAR;
          if (part) {
#pragma unroll 4
            for (int it = 0; it < 8; ++it) {
              const int rl = it * 8 + r0;
              const float4 v = *(const float4*)(st + rl * LDW + c4);
              const int grow = brow + ai * GHALF + wq * 64 + rl;
              float* pp = (float*)(wsp(P) + OFF_PART) + ((size_t)ksel * MCTX + (grow - MLAT)) * DM + bcol + c4;
              *(float4*)pp = make_float4(g4.x * v.x, g4.y * v.y, g4.z * v.z, g4.w * v.w);
            }
          } else {
#pragma unroll
            for (int gq = 0; gq < 2; ++gq) {
              float4 hq[4]; float2 msq[4];
#pragma unroll
              for (int i4 = 0; i4 < 4; ++i4) {
                const int grow = brow + ai * GHALF + wq * 64 + (gq * 4 + i4) * 8 + r0;
                if (e.plng) {
                  hq[i4] = *(const float4*)(hrow(P, grow) + bcol + c4);
                  msq[i4] = *(const float2*)((const float*)(wsp(P) + OFF_RSTAT) + (size_t)grow * 2);
                } else {
                  hq[i4] = *(const float4*)(e.hsrc + (size_t)grow * DM + bcol + c4);
                  msq[i4] = make_float2(0.f, 1.f);
                }
              }
#pragma unroll
              for (int i4 = 0; i4 < 4; ++i4) {
                const int rl = (gq * 4 + i4) * 8 + r0;
                const float4 v = *(const float4*)(st + rl * LDW + c4);
                const int grow = brow + ai * GHALF + wq * 64 + rl;
                float4 h4 = hq[i4];
                if (e.plng) {
                  const float2 ms = msq[i4];
                  h4.x = (h4.x - ms.x) * ms.y * lg4.x + lb4.x; h4.y = (h4.y - ms.x) * ms.y * lg4.y + lb4.y;
                  h4.z = (h4.z - ms.x) * ms.y * lg4.z + lb4.z; h4.w = (h4.w - ms.x) * ms.y * lg4.w + lb4.w;
                }
                h4.x = ALPHA * h4.x + g4.x * v.x; h4.y = ALPHA * h4.y + g4.y * v.y;
                h4.z = ALPHA * h4.z + g4.z * v.z; h4.w = ALPHA * h4.w + g4.w * v.w;
                *(float4*)(hrow(P, grow) + bcol + c4) = h4;
              }
            }
          }
          WAIT_L(0); BAR;
        }
      }
    } else if (MODE == EPI_ACT) {
      constexpr int LDH = 136;
      u16* st = (u16*)(smem + EPI_OFF);
#pragma unroll
      for (int ai = 0; ai < 2; ++ai)
#pragma unroll
        for (int bj = 0; bj < 2; ++bj)
#pragma unroll
          for (int m = 0; m < 4; ++m)
#pragma unroll
            for (int jj = 0; jj < 4; ++jj) {
              float av = acc[ai][bj][m][0][jj], bv = acc[ai][bj][m][1][jj];
              st[(ai * GHALF + wr * 64 + m * 16 + fq_e * 4 + jj) * LDH + bj * 64 + wc * 16 + fr_e] = f2bf(siluf_(av) * bv);
            }
      prefetch_next();
      WAIT_L(0); BAR;
      int tq = TID();
      const int pc = (tq & 15) * 8, r0 = tq >> 4;
#pragma unroll 4
      for (int it = 0; it < 8; ++it) {
        const int rl = it * 32 + r0;
        *(uint4*)(e.outbf + (size_t)(brow + rl) * e.ld + (bcol >> 1) + pc) = *(const uint4*)(st + rl * LDH + pc);
      }
      WAIT_L(0); BAR;
    } else if (MODE == EPI_PBF) {
      constexpr int LDH = 264;
      u16* st = (u16*)(smem + EPI_OFF);
      int tq = TID();
      const int pc = (tq & 31) * 8, r0 = tq >> 5;
#pragma unroll
      for (int ai = 0; ai < 2; ++ai) {
#pragma unroll
        for (int bj = 0; bj < 2; ++bj)
#pragma unroll
          for (int m = 0; m < 4; ++m)
#pragma unroll
            for (int n = 0; n < 2; ++n)
#pragma unroll
              for (int jj = 0; jj < 4; ++jj)
                st[(wr * 64 + m * 16 + fq_e * 4 + jj) * LDH + bj * GHALF + wc * 32 + n * 16 + fr_e] = f2bf(acc[ai][bj][m][n][jj]);
        if (ai == 1) prefetch_next();
        WAIT_L(0); BAR;
#pragma unroll 4
        for (int it = 0; it < 8; ++it) {
          const int rl = it * 16 + r0;
          *(uint4*)(e.outbf + (size_t)(brow + ai * GHALF + rl) * e.ld + bcol + pc) = *(const uint4*)(st + rl * LDH + pc);
        }
        WAIT_L(0); BAR;
      }
    } else {
#pragma unroll
      for (int ai = 0; ai < 2; ++ai)
#pragma unroll
        for (int bj = 0; bj < 2; ++bj)
#pragma unroll
          for (int m = 0; m < 4; ++m)
#pragma unroll
            for (int jj = 0; jj < 4; ++jj) {
              const int row = brow + ai * GHALF + wr * 64 + m * 16 + fq_e * 4 + jj;
#pragma unroll
              for (int n = 0; n < 2; ++n) {
                const int col = bcol + bj * GHALF + wc * 32 + n * 16 + fr_e;
                float v = acc[ai][bj][m][n][jj];
                float z = bf2f(e.zbuf[(size_t)row * 256 + col]);
                e.outbf[(size_t)row * e.ld + col] = f2bf(z * sigmoidf_(v + e.glub[col]));
              }
            }
      prefetch_next();
    }
    WAIT_V(0);
    BAR;
  }
#undef SA
#undef SB
#undef STAGE
#undef LDA
#undef LDB
#undef MMA
}

__device__ __forceinline__ void chunk_map(int ci, int dir, int b, int& t0, int& L, int& rowbase, bool& isctx) {
  isctx = ci < 4;
  int cc = isctx ? ci : ci - 4;
  int nch = isctx ? 4 : 64;
  int cn = dir ? nch - 1 - cc : cc;
  t0 = cn * 64;
  L = isctx ? 256 : 4096;
  rowbase = isctx ? MLAT + b * 256 : b * 4096;
}

__device__ __forceinline__ void ld8(const u16* p, float* o) {
  uint4 u = *(const uint4*)p;
  o[0] = lo16(u.x); o[1] = hi16(u.x); o[2] = lo16(u.y); o[3] = hi16(u.y);
  o[4] = lo16(u.z); o[5] = hi16(u.z); o[6] = lo16(u.w); o[7] = hi16(u.w);
}
__device__ __forceinline__ void ld4(const u16* p, float* o) {
  uint2 u = *(const uint2*)p;
  o[0] = lo16(u.x); o[1] = hi16(u.x); o[2] = lo16(u.y); o[3] = hi16(u.y);
}

typedef float v2f __attribute__((ext_vector_type(2)));
__device__ __forceinline__ void unpack8(uint4 u, float* o) {
  o[0] = lo16(u.x); o[1] = hi16(u.x); o[2] = lo16(u.y); o[3] = hi16(u.y);
  o[4] = lo16(u.z); o[5] = hi16(u.z); o[6] = lo16(u.w); o[7] = hi16(u.w);
}
__device__ __forceinline__ uint4 ldz4(const u16* p, bool ok) {
  uint4 v = *(const uint4*)p;
  v.x = ok ? v.x : 0u; v.y = ok ? v.y : 0u; v.z = ok ? v.z : 0u; v.w = ok ? v.w : 0u;
  return v;
}
__device__ __forceinline__ uint2 ldz2(const u16* p, bool ok) {
  uint2 v = *(const uint2*)p;
  v.x = ok ? v.x : 0u; v.y = ok ? v.y : 0u;
  return v;
}
template <int MODE>
__device__ __forceinline__ void colscan_item(const Params& P, int item, int j) {
  extern __shared__ __attribute__((aligned(16))) char smem[];
  float* sCW = (float*)smem;
  float* sSc = sCW + 1600;
  float* sV = sSc + 256;
  float* sO = sV + 4096;
  float* sK = sO + 4096;
  float* sQ = sK + 8192;
  u16* sRaw = (u16*)(sQ + 8192);
  const int tid = TID(), lane = tid & 63, wid = tid >> 6;
  const int half = item & 1, chain = item >> 1, dir = chain & 1, hb = chain >> 1;
  constexpr int H = MODE == 0 ? 4 : 6;
  constexpr int NP = MODE == 0 ? CD_NP : AB_NP;
  const int h = hb % H, b = hb / H;
  const int qc = MODE == 0 ? h * 128 : 256 + h * 128;
  const int kc = MODE == 0 ? 512 + h * 128 : 1024 + h * 128;
  const int vc = (MODE == 0 ? 1024 : 1792) + h * 128 + half * 64;
  const int ocol = (MODE == 0 ? 0 : 256) + h * 128 + half * 64;
  const u16* p = (const u16*)(wsp(P) + OFF_R);
  u16* od = (u16*)(wsp(P) + OFF_OUTDIR) + (size_t)dir * MROWS * DM;
  const float* rope = (const float*)(wsp(P) + OFF_ROPE);
  float c_a = 0.f, c_b = 0.f;
  if (MODE == 0) {
    c_a = -expf(inp(P, I_ALOG)[(j * 2 + dir) * 4 + h]);
    c_b = inp(P, I_DTB)[(j * 2 + dir) * 4 + h];
    const float* cw = inp(P, I_CONVW) + (size_t)j * 5 * 1536;
    for (int i = tid; i < 1600; i += NT) {
      float v;
      if (i < 640) { int tap = i >> 7, c = i & 127; v = cw[tap * 1536 + h * 128 + c]; }
      else if (i < 1280) { int q = i - 640; int tap = q >> 7, c = q & 127; v = cw[tap * 1536 + 512 + h * 128 + c]; }
      else { int q = i - 1280; int tap = q >> 6, c = q & 63; v = cw[tap * 1536 + 1024 + h * 128 + half * 64 + c]; }
      sCW[i] = v;
    }
  } else {
    c_a = expf(-expf(inp(P, I_RETLR)[(j * 2 + dir) * 6 + h]));
  }
  v2f S0[8], S1[8];
#pragma unroll
  for (int i = 0; i < 8; ++i) { S0[i] = (v2f){0.f, 0.f}; S1[i] = (v2f){0.f, 0.f}; }
  const int l8 = lane & 7, col = (wid & 3) * 16 + (lane >> 3) * 2;
  const int t = tid >> 3, part = tid & 7;
  uint4 rq0, rq1, rk0, rk1, rv;
  auto prefetch = [&](int ci) {
    int t0, L, rowbase; bool isctx;
    chunk_map(ci, dir, b, t0, L, rowbase, isctx);
    const u16* pr = p + ((size_t)rowbase + t0 + t) * NP;
    rq0 = *(const uint4*)(pr + qc + part * 8);
    rq1 = *(const uint4*)(pr + qc + 64 + part * 8);
    rk0 = *(const uint4*)(pr + kc + part * 8);
    rk1 = *(const uint4*)(pr + kc + 64 + part * 8);
    rv = *(const uint4*)(pr + vc + part * 8);
  };
  rq0 = rq1 = rk0 = rk1 = rv = make_uint4(0, 0, 0, 0);
  if (MODE != 0) prefetch(0);
  __syncthreads();
  const int t_c = tid >> 3, part_c = tid & 7;
  for (int ci = 0; ci < 68; ++ci) {
    int t0, L, rowbase; bool isctx;
    chunk_map(ci, dir, b, t0, L, rowbase, isctx);
    int t = t_c, part = part_c;
    asm volatile("" : "+v"(t), "+v"(part));

    {
      const int tt = t0 + t;
      if (MODE == 0) {
        unsigned rab_;
        {
          const u16* pr = p + ((size_t)rowbase + tt) * NP;
          uint4 a0 = *(const uint4*)(pr + qc + part * 16), a1 = *(const uint4*)(pr + qc + part * 16 + 8);
          uint4 b0 = *(const uint4*)(pr + kc + part * 16), b1 = *(const uint4*)(pr + kc + part * 16 + 8);
          uint4 c0 = *(const uint4*)(pr + vc + part * 8);
          rab_ = (unsigned)pr[2048 + dir * 4 + h] | ((unsigned)pr[2056 + dir * 4 + h] << 16);
          u16* rr = sRaw + (t + 2) * 320;
          *(uint4*)(rr + part * 16) = a0; *(uint4*)(rr + part * 16 + 8) = a1;
          *(uint4*)(rr + 128 + part * 16) = b0; *(uint4*)(rr + 128 + part * 16 + 8) = b1;
          *(uint4*)(rr + 256 + part * 8) = c0;
          if (t < 4) {
            const int ts = t < 2 ? t0 - 2 + t : t0 + 62 + t;
            const bool ok = ts >= 0 && ts < L;
            const u16* ph = p + ((size_t)rowbase + (ok ? ts : tt)) * NP;
            u16* hh = sRaw + (t < 2 ? t : 64 + t) * 320;
            *(uint4*)(hh + part * 16) = ldz4(ph + qc + part * 16, ok); *(uint4*)(hh + part * 16 + 8) = ldz4(ph + qc + part * 16 + 8, ok);
            *(uint4*)(hh + 128 + part * 16) = ldz4(ph + kc + part * 16, ok); *(uint4*)(hh + 128 + part * 16 + 8) = ldz4(ph + kc + part * 16 + 8, ok);
            *(uint4*)(hh + 256 + part * 8) = ldz4(ph + vc + part * 8, ok);
          }
        }
        __syncthreads();
        float q[16], k[16], v[8];
#pragma unroll
        for (int i = 0; i < 16; ++i) { q[i] = 0.f; k[i] = 0.f; }
#pragma unroll
        for (int i = 0; i < 8; ++i) v[i] = 0.f;
#pragma unroll
        for (int tap = 0; tap < 5; ++tap) {
          const u16* rr = sRaw + (t + tap) * 320;
          float x[16];
          unpack8(*(const uint4*)(rr + part * 16), x); unpack8(*(const uint4*)(rr + part * 16 + 8), x + 8);
#pragma unroll
          for (int i = 0; i < 16; ++i) q[i] += x[i] * sCW[tap * 128 + part * 16 + i];
          unpack8(*(const uint4*)(rr + 128 + part * 16), x); unpack8(*(const uint4*)(rr + 128 + part * 16 + 8), x + 8);
#pragma unroll
          for (int i = 0; i < 16; ++i) k[i] += x[i] * sCW[640 + tap * 128 + part * 16 + i];
          unpack8(*(const uint4*)(rr + 256 + part * 8), x);
#pragma unroll
          for (int i = 0; i < 8; ++i) v[i] += x[i] * sCW[1280 + tap * 64 + part * 8 + i];
        }
        float sq = 0.f, sk = 0.f;
#pragma unroll
        for (int i = 0; i < 16; ++i) { q[i] = siluf_(q[i]); k[i] = siluf_(k[i]); sq += q[i] * q[i]; sk += k[i] * k[i]; }
        sq = reduce8(sq); sk = reduce8(sk);
        float rq = rsqrtf(sq + 1e-6f) * 0.08838834764831845f, rk = rsqrtf(sk + 1e-6f);
        float qk = 0.f;
#pragma unroll
        for (int i = 0; i < 16; ++i) { q[i] *= rq; k[i] *= rk; qk += q[i] * k[i]; }
        qk = reduce8(qk);
#pragma unroll
        for (int i = 0; i < 16; i += 4) {
          *(float4*)(sQ + t * 128 + part * 16 + i) = make_float4(q[i], q[i + 1], q[i + 2], q[i + 3]);
          *(float4*)(sK + t * 128 + part * 16 + i) = make_float4(k[i], k[i + 1], k[i + 2], k[i + 3]);
        }
        *(float4*)(sV + t * 64 + part * 8) = make_float4(siluf_(v[0]), siluf_(v[1]), siluf_(v[2]), siluf_(v[3]));
        *(float4*)(sV + t * 64 + part * 8 + 4) = make_float4(siluf_(v[4]), siluf_(v[5]), siluf_(v[6]), siluf_(v[7]));
        if (part == 0) {
          float ain = lo16(rab_), bin = hi16(rab_);
          *(float4*)(sSc + t * 4) = make_float4(__expf(c_a * softplusf_(ain + c_b)), sigmoidf_(bin), qk, 0.f);
        }
      } else {
        float q1[8], q2[8], k1[8], k2[8], v[8];
        unpack8(rq0, q1); unpack8(rq1, q2); unpack8(rk0, k1); unpack8(rk1, k2); unpack8(rv, v);
        if (!isctx) {
          int pos = part < 4 ? (tt >> 6) : (tt & 63);
          int f0 = (part & 3) * 8;
#pragma unroll
          for (int i = 0; i < 8; ++i) {
            float2 cs = *(const float2*)(rope + (pos * 32 + f0 + i) * 2);
            float a = q1[i], bb = q2[i];
            q1[i] = a * cs.x - bb * cs.y; q2[i] = a * cs.y + bb * cs.x;
            a = k1[i]; bb = k2[i];
            k1[i] = a * cs.x - bb * cs.y; k2[i] = a * cs.y + bb * cs.x;
          }
        }
        float qk = 0.f;
#pragma unroll
        for (int i = 0; i < 8; ++i) {
          k1[i] *= 0.08838834764831845f; k2[i] *= 0.08838834764831845f;
          qk += q1[i] * k1[i] + q2[i] * k2[i];
        }
        qk = reduce8(qk);
#pragma unroll
        for (int i = 0; i < 8; i += 4) {
          *(float4*)(sQ + t * 128 + part * 8 + i) = make_float4(q1[i], q1[i + 1], q1[i + 2], q1[i + 3]);
          *(float4*)(sQ + t * 128 + 64 + part * 8 + i) = make_float4(q2[i], q2[i + 1], q2[i + 2], q2[i + 3]);
          *(float4*)(sK + t * 128 + part * 8 + i) = make_float4(k1[i], k1[i + 1], k1[i + 2], k1[i + 3]);
          *(float4*)(sK + t * 128 + 64 + part * 8 + i) = make_float4(k2[i], k2[i + 1], k2[i + 2], k2[i + 3]);
        }
        *(float4*)(sV + t * 64 + part * 8) = make_float4(v[0], v[1], v[2], v[3]);
        *(float4*)(sV + t * 64 + part * 8 + 4) = make_float4(v[4], v[5], v[6], v[7]);
        if (part == 0) *(float4*)(sSc + t * 4) = make_float4(c_a, 1.0f, qk, 0.f);
      }
    }
    __syncthreads();
    if (MODE != 0 && ci + 1 < 68) prefetch(ci + 1);
    if (wid < 4) {
#pragma unroll 1
      for (int i = 0; i < 64; ++i) {
        const int ts = dir ? 63 - i : i;
        v2f kk[8], qq[8];
#pragma unroll
        for (int u = 0; u < 4; ++u) {
          float4 kx = *(const float4*)(sK + ts * 128 + u * 32 + l8 * 4);
          float4 qx = *(const float4*)(sQ + ts * 128 + u * 32 + l8 * 4);
          kk[2 * u] = (v2f){kx.x, kx.y}; kk[2 * u + 1] = (v2f){kx.z, kx.w};
          qq[2 * u] = (v2f){qx.x, qx.y}; qq[2 * u + 1] = (v2f){qx.z, qx.w};
        }
        const float4 sc = *(const float4*)(sSc + ts * 4);
        const float2 vv = *(const float2*)(sV + ts * 64 + col);
        const float a = sc.x, qk = sc.z;
        v2f aq0 = qq[0] * S0[0], aq1 = qq[0] * S1[0];
#pragma unroll
        for (int u = 1; u < 8; ++u) { aq0 += qq[u] * S0[u]; aq1 += qq[u] * S1[u]; }
        const float pq0 = reduce8(aq0.x + aq0.y), pq1 = reduce8(aq1.x + aq1.y);
        float vn0, vn1;
        if (MODE == 0) {
          v2f ak0 = kk[0] * S0[0], ak1 = kk[0] * S1[0];
#pragma unroll
          for (int u = 1; u < 8; ++u) { ak0 += kk[u] * S0[u]; ak1 += kk[u] * S1[u]; }
          const float pk0 = reduce8(ak0.x + ak0.y), pk1 = reduce8(ak1.x + ak1.y);
          vn0 = sc.y * (vv.x - a * pk0); vn1 = sc.y * (vv.y - a * pk1);
        } else {
          vn0 = vv.x; vn1 = vv.y;
        }
        const float o0 = a * pq0 + qk * vn0, o1 = a * pq1 + qk * vn1;
        const v2f a2 = (v2f){a, a}, v20 = (v2f){vn0, vn0}, v21 = (v2f){vn1, vn1};
#pragma unroll
        for (int u = 0; u < 8; ++u) { S0[u] = a2 * S0[u] + kk[u] * v20; S1[u] = a2 * S1[u] + kk[u] * v21; }
        if (l8 == 0) *(float2*)(sO + ts * 64 + col) = make_float2(o0, o1);
      }
    }
    __syncthreads();
    {
      float4 o0 = *(const float4*)(sO + t * 64 + part * 8), o1 = *(const float4*)(sO + t * 64 + part * 8 + 4);
      uint4 u; u.x = pack2(o0.x, o0.y); u.y = pack2(o0.z, o0.w); u.z = pack2(o1.x, o1.y); u.w = pack2(o1.z, o1.w);
      const int tf = t;
      *(uint4*)(od + ((size_t)rowbase + t0 + tf) * DM + ocol + part * 8) = u;
    }
  }
  __syncthreads();
}

__device__ __forceinline__ uint4 pack8bf(const float* x) {
  uint4 u; u.x = pack2(x[0], x[1]); u.y = pack2(x[2], x[3]); u.z = pack2(x[4], x[5]); u.w = pack2(x[6], x[7]); return u;
}
__device__ __forceinline__ void ret_item(const Params& P, int item, int j) {
  extern __shared__ __attribute__((aligned(16))) char smem[];
  u16* sQ = (u16*)smem;
  u16* sK = sQ + 64 * 136;
  u16* sKT = sK + 64 * 136;
  u16* sVT = sKT + 128 * 72;
  u16* sA = sVT + 128 * 72;
  u16* sOut = sA + 64 * 72;
  const int tid = TID(), lane = tid & 63, wid = tid >> 6, fr = lane & 15, fq = lane >> 4;
  const int dir = item & 1, hb = item >> 1, h = hb % 6, b = hb / 6;
  const int qc = 256 + h * 128, kc = 1024 + h * 128, vc = 1792 + h * 128, ocol = 256 + h * 128;
  const u16* p = (const u16*)(wsp(P) + OFF_R);
  u16* od = (u16*)(wsp(P) + OFF_OUTDIR) + (size_t)dir * MROWS * DM;
  float* sRope = (float*)(sOut + 64 * 136);
  {
    const float* rope_g = (const float*)(wsp(P) + OFF_ROPE);
    for (int i = tid; i < 1024; i += NT) *(float4*)(sRope + i * 4) = *(const float4*)(rope_g + i * 4);
  }
  const float* rope = sRope;
  const float lg = -expf(inp(P, I_RETLR)[(j * 2 + dir) * 6 + h]) * 1.4426950408889634f;
  f32x4 accS[8];
#pragma unroll
  for (int i = 0; i < 8; ++i) accS[i] = (f32x4){0.f, 0.f, 0.f, 0.f};
  const int tl_c = tid >> 3, part_c = tid & 7;
  uint4 rq0, rq1, rk0, rk1, rv0, rv1;
  auto prefetch = [&](int ci) {
    int t0, L, rowbase; bool isctx;
    chunk_map(ci, dir, b, t0, L, rowbase, isctx);
    const u16* pr = p + ((size_t)rowbase + t0 + tl_c) * AB_NP;
    rq0 = *(const uint4*)(pr + qc + part_c * 8);
    rq1 = *(const uint4*)(pr + qc + 64 + part_c * 8);
    rk0 = *(const uint4*)(pr + kc + part_c * 8);
    rk1 = *(const uint4*)(pr + kc + 64 + part_c * 8);
    rv0 = *(const uint4*)(pr + vc + part_c * 16);
    rv1 = *(const uint4*)(pr + vc + part_c * 16 + 8);
  };
  prefetch(0);
  __syncthreads();
  for (int ci = 0; ci < 68; ++ci) {
    int t0, L, rowbase; bool isctx;
    chunk_map(ci, dir, b, t0, L, rowbase, isctx);
    int tl = tl_c, part = part_c;
    asm volatile("" : "+v"(tl), "+v"(part));
    const int ip = dir ? 63 - tl : tl;
    {
      const int tt = t0 + tl;
      float q1[8], q2[8], k1[8], k2[8];
      unpack8(rq0, q1); unpack8(rq1, q2); unpack8(rk0, k1); unpack8(rk1, k2);
      if (!isctx) {
        const int pos = part < 4 ? (tt >> 6) : (tt & 63);
        const int f0 = (part & 3) * 8;
#pragma unroll
        for (int i = 0; i < 8; ++i) {
          float2 cs = *(const float2*)(rope + (pos * 32 + f0 + i) * 2);
          float a = q1[i], bb = q2[i];
          q1[i] = a * cs.x - bb * cs.y; q2[i] = a * cs.y + bb * cs.x;
          a = k1[i]; bb = k2[i];
          k1[i] = a * cs.x - bb * cs.y; k2[i] = a * cs.y + bb * cs.x;
        }
      }
#pragma unroll
      for (int i = 0; i < 8; ++i) { k1[i] *= 0.08838834764831845f; k2[i] *= 0.08838834764831845f; }
      *(uint4*)(sQ + ip * 136 + part * 8) = pack8bf(q1);
      *(uint4*)(sQ + ip * 136 + 64 + part * 8) = pack8bf(q2);
      *(uint4*)(sK + ip * 136 + part * 8) = pack8bf(k1);
      *(uint4*)(sK + ip * 136 + 64 + part * 8) = pack8bf(k2);
      const float dk = exp2f((float)(63 - ip) * lg);
#pragma unroll
      for (int u = 0; u < 8; ++u) {
        sKT[(part * 8 + u) * 72 + ip] = f2bf(k1[u] * dk);
        sKT[(64 + part * 8 + u) * 72 + ip] = f2bf(k2[u] * dk);
      }
      const unsigned vw[8] = {rv0.x, rv0.y, rv0.z, rv0.w, rv1.x, rv1.y, rv1.z, rv1.w};
#pragma unroll
      for (int u = 0; u < 8; ++u) {
        sVT[(part * 16 + 2 * u) * 72 + ip] = (u16)(vw[u] & 0xffffu);
        sVT[(part * 16 + 2 * u + 1) * 72 + ip] = (u16)(vw[u] >> 16);
      }
    }
    __syncthreads();
    if (ci + 1 < 68) prefetch(ci + 1);
#pragma unroll
    for (int tt = 0; tt < 2; ++tt) {
      const int tile = wid * 2 + tt, mi = tile >> 2, nj = tile & 3;
      f32x4 acc = (f32x4){0.f, 0.f, 0.f, 0.f};
      if (nj <= mi) {
#pragma unroll
        for (int kb = 0; kb < 4; ++kb) {
          bf16x8 a = *reinterpret_cast<const bf16x8*>(sQ + (mi * 16 + fr) * 136 + kb * 32 + fq * 8);
          bf16x8 bb = *reinterpret_cast<const bf16x8*>(sK + (nj * 16 + fr) * 136 + kb * 32 + fq * 8);
          acc = __builtin_amdgcn_mfma_f32_16x16x32_bf16(a, bb, acc, 0, 0, 0);
        }
      }
#pragma unroll
      for (int rr = 0; rr < 4; ++rr) {
        const int i = mi * 16 + fq * 4 + rr, jx = nj * 16 + fr;
        const float val = (jx <= i) ? acc[rr] * exp2f((float)(i - jx) * lg) : 0.0f;
        sA[i * 72 + jx] = f2bf(val);
      }
    }
    __syncthreads();
    {
      const int e0 = wid * 16;
      f32x4 o[4];
#pragma unroll
      for (int m = 0; m < 4; ++m) o[m] = (f32x4){0.f, 0.f, 0.f, 0.f};
#pragma unroll
      for (int kb = 0; kb < 4; ++kb) {
        uint4 sb;
        sb.x = pack2(accS[2 * kb][0], accS[2 * kb][1]); sb.y = pack2(accS[2 * kb][2], accS[2 * kb][3]);
        sb.z = pack2(accS[2 * kb + 1][0], accS[2 * kb + 1][1]); sb.w = pack2(accS[2 * kb + 1][2], accS[2 * kb + 1][3]);
        const bf16x8 bS = __builtin_bit_cast(bf16x8, sb);
#pragma unroll
        for (int m = 0; m < 4; ++m) {
          uint2 a0 = *(const uint2*)(sQ + (m * 16 + fr) * 136 + kb * 32 + fq * 4);
          uint2 a1 = *(const uint2*)(sQ + (m * 16 + fr) * 136 + kb * 32 + 16 + fq * 4);
          uint4 au; au.x = a0.x; au.y = a0.y; au.z = a1.x; au.w = a1.y;
          o[m] = __builtin_amdgcn_mfma_f32_16x16x32_bf16(__builtin_bit_cast(bf16x8, au), bS, o[m], 0, 0, 0);
        }
      }
#pragma unroll
      for (int m = 0; m < 4; ++m)
#pragma unroll
        for (int rr = 0; rr < 4; ++rr) o[m][rr] *= exp2f((float)(m * 16 + fq * 4 + rr + 1) * lg);
      bf16x8 bV[2];
#pragma unroll
      for (int jb = 0; jb < 2; ++jb) bV[jb] = *reinterpret_cast<const bf16x8*>(sVT + (e0 + fr) * 72 + jb * 32 + fq * 8);
#pragma unroll
      for (int m = 0; m < 4; ++m)
#pragma unroll
        for (int jb = 0; jb < 2; ++jb) {
          bf16x8 a = *reinterpret_cast<const bf16x8*>(sA + (m * 16 + fr) * 72 + jb * 32 + fq * 8);
          o[m] = __builtin_amdgcn_mfma_f32_16x16x32_bf16(a, bV[jb], o[m], 0, 0, 0);
        }
#pragma unroll
      for (int m = 0; m < 4; ++m)
#pragma unroll
        for (int rr = 0; rr < 4; ++rr) sOut[(m * 16 + fq * 4 + rr) * 136 + e0 + fr] = f2bf(o[m][rr]);
      const float cd = exp2f(64.0f * lg);
#pragma unroll
      for (int td = 0; td < 8; ++td) {
        accS[td][0] *= cd; accS[td][1] *= cd; accS[td][2] *= cd; accS[td][3] *= cd;
#pragma unroll
        for (int jb = 0; jb < 2; ++jb) {
          bf16x8 a = *reinterpret_cast<const bf16x8*>(sKT + (td * 16 + fr) * 72 + jb * 32 + fq * 8);
          accS[td] = __builtin_amdgcn_mfma_f32_16x16x32_bf16(a, bV[jb], accS[td], 0, 0, 0);
        }
      }
    }
    __syncthreads();
    {
      uint4 u0 = *(const uint4*)(sOut + ip * 136 + part * 16), u1 = *(const uint4*)(sOut + ip * 136 + part * 16 + 8);
      u16* dst = od + ((size_t)rowbase + t0 + tl) * DM + ocol + part * 16;
      *(uint4*)dst = u0; *(uint4*)(dst + 8) = u1;
    }
  }
  __syncthreads();
}

__device__ __forceinline__ void shiftmix8(uint4 c, uint4 m, uint4 n, const float* mu, float* o) {
  float cf[8], mf[8], nf[8];
  unpack8(c, cf); unpack8(m, mf); unpack8(n, nf);
  float4 m0 = *(const float4*)mu, m1 = *(const float4*)(mu + 4);
  float mv[8] = {m0.x, m0.y, m0.z, m0.w, m1.x, m1.y, m1.z, m1.w};
#pragma unroll
  for (int i = 0; i < 8; ++i) o[i] = cf[i] + mv[i] * (0.5f * (mf[i] + nf[i]) - cf[i]);
}
__device__ __forceinline__ float shift8(const u16* pc, const u16* pm, const u16* pp, const float* mu, float* o) {
  shiftmix8(*(const uint4*)pc, ldz4(pm ? pm : pc, pm != nullptr), ldz4(pp ? pp : pc, pp != nullptr), mu, o);
  return 0.f;
}

__device__ __forceinline__ void rwkv_item(const Params& P, int item, int j) {
  extern __shared__ __attribute__((aligned(16))) char smem[];
  float* sAv = (float*)smem;
  float* sRW = sAv + 4096;
  float* sW = sRW + 4096;
  float* sBv = sW + 4096;
  float* sKD = sBv + 4096;
  float* sV = sKD + 4096;
  float* sY = sV + 4096;
  float* sSc = sY + 4096;
  float* sLin = sSc + 256;
  float* sWup = sLin + 4096;
  float* sAup = sWup + 2048;
  const int tid = TID(), lane = tid & 63, wid = tid >> 6;
  const int chain = item, dir = chain & 1, hb = chain >> 1, h = hb & 7, b = hb >> 3;
  const u16* p = (const u16*)(wsp(P) + OFF_R);
  u16* od = (u16*)(wsp(P) + OFF_OUTDIR) + (size_t)dir * MROWS * DM;
  float* bonus = (float*)(wsp(P) + OFF_BONUS) + (size_t)dir * MROWS * 8;
  const float* mu = inp(P, I_MU) + (size_t)j * 1760;
  {
    const float* wup = inp(P, I_WUP) + (size_t)(j * 2 + dir) * 32 * 512;
    const float* aup = inp(P, I_AUP) + (size_t)(j * 2 + dir) * 32 * 512;
    for (int i = tid; i < 2048; i += NT) {
      int l = i >> 6, c = i & 63;
      sWup[i] = wup[l * 512 + h * 64 + c];
      sAup[i] = aup[l * 512 + h * 64 + c];
    }
  }
  v2f S0[4], S1[4];
#pragma unroll
  for (int i = 0; i < 4; ++i) { S0[i] = (v2f){0.f, 0.f}; S1[i] = (v2f){0.f, 0.f}; }
  const int l8 = lane & 7, rowi = (wid & 3) * 16 + (lane >> 3) * 2;
  constexpr int RB = 2064;
  const int t_c = tid >> 3, j8_c = tid & 7;
  uint4 pr_[3], pk_[3], pv_[3];
  uint2 pw_[3], pa_[3];
  auto prefetch = [&](int ci) {
    int t0, L, rowbase; bool isctx;
    chunk_map(ci, dir, b, t0, L, rowbase, isctx);
    int t = t_c, j8 = j8_c;
    asm volatile("" : "+v"(t), "+v"(j8));
    const int hc = h * 64 + j8 * 8;
    const int cw = 1536 + dir * 32 + j8 * 4, ca = 1600 + dir * 32 + j8 * 4;
    const int tt = t0 + t;
#pragma unroll
    for (int d = 0; d < 3; ++d) {
      const int ts = tt + d - 1;
      const bool ok = ts >= 0 && ts < L;
      const u16* pc = p + ((size_t)rowbase + (ok ? ts : tt)) * CD_NP + RB;
      pr_[d] = ldz4(pc + hc, ok);
      pk_[d] = ldz4(pc + 512 + hc, ok);
      pv_[d] = ldz4(pc + 1024 + hc, ok);
      pw_[d] = ldz2(pc + cw, ok);
      pa_[d] = ldz2(pc + ca, ok);
    }
  };
  prefetch(0);
  __syncthreads();
  for (int ci = 0; ci < 68; ++ci) {
    int t0, L, rowbase; bool isctx;
    chunk_map(ci, dir, b, t0, L, rowbase, isctx);
    int t = t_c, j8 = j8_c;
    asm volatile("" : "+v"(t), "+v"(j8));
    const int hc = h * 64 + j8 * 8;
    const int cw = 1536 + dir * 32 + j8 * 4, ca = 1600 + dir * 32 + j8 * 4;
    const size_t row = (size_t)rowbase + t0 + t;
    {
      float c[4], m[4], n[4];
      c[0] = lo16(pw_[1].x); c[1] = hi16(pw_[1].x); c[2] = lo16(pw_[1].y); c[3] = hi16(pw_[1].y);
      m[0] = lo16(pw_[0].x); m[1] = hi16(pw_[0].x); m[2] = lo16(pw_[0].y); m[3] = hi16(pw_[0].y);
      n[0] = lo16(pw_[2].x); n[1] = hi16(pw_[2].x); n[2] = lo16(pw_[2].y); n[3] = hi16(pw_[2].y);
#pragma unroll
      for (int i = 0; i < 4; ++i) sLin[t * 64 + j8 * 4 + i] = tanhf(c[i] + mu[cw + i] * (0.5f * (m[i] + n[i]) - c[i]));
      c[0] = lo16(pa_[1].x); c[1] = hi16(pa_[1].x); c[2] = lo16(pa_[1].y); c[3] = hi16(pa_[1].y);
      m[0] = lo16(pa_[0].x); m[1] = hi16(pa_[0].x); m[2] = lo16(pa_[0].y); m[3] = hi16(pa_[0].y);
      n[0] = lo16(pa_[2].x); n[1] = hi16(pa_[2].x); n[2] = lo16(pa_[2].y); n[3] = hi16(pa_[2].y);
#pragma unroll
      for (int i = 0; i < 4; ++i) sLin[t * 64 + 32 + j8 * 4 + i] = c[i] + mu[ca + i] * (0.5f * (m[i] + n[i]) - c[i]);
    }
    float r[8], k[8], v[8];
    shiftmix8(pr_[1], pr_[0], pr_[2], mu + hc, r);
    shiftmix8(pk_[1], pk_[0], pk_[2], mu + 512 + hc, k);
    shiftmix8(pv_[1], pv_[0], pv_[2], mu + 1024 + hc, v);
    __syncthreads();
    {
      float lw[8], la[8];
      {
        const float* w0 = inp(P, I_W0) + (size_t)(j * 2 + dir) * 512 + hc;
        const float* a0 = inp(P, I_A0) + (size_t)(j * 2 + dir) * 512 + hc;
#pragma unroll
        for (int i = 0; i < 8; ++i) { lw[i] = w0[i]; la[i] = a0[i]; }
      }
#pragma unroll 4
      for (int l = 0; l < 32; ++l) {
        float x = sLin[t * 64 + l], y = sLin[t * 64 + 32 + l];
        float4 wa = *(const float4*)(sWup + l * 64 + j8 * 8), wb = *(const float4*)(sWup + l * 64 + j8 * 8 + 4);
        float4 aa = *(const float4*)(sAup + l * 64 + j8 * 8), ab = *(const float4*)(sAup + l * 64 + j8 * 8 + 4);
        lw[0] += x * wa.x; lw[1] += x * wa.y; lw[2] += x * wa.z; lw[3] += x * wa.w;
        lw[4] += x * wb.x; lw[5] += x * wb.y; lw[6] += x * wb.z; lw[7] += x * wb.w;
        la[0] += y * aa.x; la[1] += y * aa.y; la[2] += y * aa.z; la[3] += y * aa.w;
        la[4] += y * ab.x; la[5] += y * ab.y; la[6] += y * ab.z; la[7] += y * ab.w;
      }
      const float* kkp = inp(P, I_KK) + (size_t)j * 512 + hc;
      const float* kap = inp(P, I_KA) + (size_t)j * 512 + hc;
      const float* rkp = inp(P, I_RK) + (size_t)(j * 8 + h) * 64 + j8 * 8;
      float kx[8], ss = 0.f;
#pragma unroll
      for (int i = 0; i < 8; ++i) { kx[i] = k[i] * kkp[i]; ss += kx[i] * kx[i]; }
      ss = reduce8(ss);
      float rn = rsqrtf(ss + 1e-6f);
      float av[8], rw[8], wv[8], bv[8], kd[8];
      float rb = 0.f, rk = 0.f, bon = 0.f;
      float one = 1.0f;
      asm volatile("" : "+v"(one));
#pragma unroll
      for (int i = 0; i < 8; ++i) {
        float w = __expf(-0.6065306597126334f * __builtin_amdgcn_rcpf(one + __expf(-lw[i])));
        float aa = __builtin_amdgcn_rcpf(one + __expf(-la[i]));
        float kk = kx[i] * rn;
        kd[i] = k[i] * (one + (aa - one) * kap[i]);
        av[i] = -kk; bv[i] = kk * aa; rw[i] = r[i] * w; wv[i] = w;
        rb += r[i] * bv[i]; rk += r[i] * kd[i]; bon += r[i] * kd[i] * rkp[i];
      }
      rb = reduce8(rb); rk = reduce8(rk); bon = reduce8(bon);
      const int o = t * 64 + j8 * 8;
      *(float4*)(sAv + o) = make_float4(av[0], av[1], av[2], av[3]); *(float4*)(sAv + o + 4) = make_float4(av[4], av[5], av[6], av[7]);
      *(float4*)(sRW + o) = make_float4(rw[0], rw[1], rw[2], rw[3]); *(float4*)(sRW + o + 4) = make_float4(rw[4], rw[5], rw[6], rw[7]);
      *(float4*)(sW + o) = make_float4(wv[0], wv[1], wv[2], wv[3]); *(float4*)(sW + o + 4) = make_float4(wv[4], wv[5], wv[6], wv[7]);
      *(float4*)(sBv + o) = make_float4(bv[0], bv[1], bv[2], bv[3]); *(float4*)(sBv + o + 4) = make_float4(bv[4], bv[5], bv[6], bv[7]);
      *(float4*)(sKD + o) = make_float4(kd[0], kd[1], kd[2], kd[3]); *(float4*)(sKD + o + 4) = make_float4(kd[4], kd[5], kd[6], kd[7]);
      *(float4*)(sV + o) = make_float4(v[0], v[1], v[2], v[3]); *(float4*)(sV + o + 4) = make_float4(v[4], v[5], v[6], v[7]);
      if (j8 == 0) {
        *(float2*)(sSc + t * 4) = make_float2(rb, rk);
        bonus[row * 8 + h] = bon;
      }
    }
    __syncthreads();
    if (ci + 1 < 68) prefetch(ci + 1);
    if (wid < 4) {
#pragma unroll 2
      for (int i = 0; i < 64; ++i) {
        const int ts = dir ? 63 - i : i;
        v2f a2[4], r2[4], w2[4], b2[4], k2[4];
#pragma unroll
        for (int u = 0; u < 2; ++u) {
          const int o = ts * 64 + u * 32 + l8 * 4;
          float4 x;
          x = *(const float4*)(sAv + o); a2[2 * u] = (v2f){x.x, x.y}; a2[2 * u + 1] = (v2f){x.z, x.w};
          x = *(const float4*)(sRW + o); r2[2 * u] = (v2f){x.x, x.y}; r2[2 * u + 1] = (v2f){x.z, x.w};
          x = *(const float4*)(sW + o); w2[2 * u] = (v2f){x.x, x.y}; w2[2 * u + 1] = (v2f){x.z, x.w};
          x = *(const float4*)(sBv + o); b2[2 * u] = (v2f){x.x, x.y}; b2[2 * u + 1] = (v2f){x.z, x.w};
          x = *(const float4*)(sKD + o); k2[2 * u] = (v2f){x.x, x.y}; k2[2 * u + 1] = (v2f){x.z, x.w};
        }
        const float2 sc = *(const float2*)(sSc + ts * 4);
        const float2 vv = *(const float2*)(sV + ts * 64 + rowi);
        v2f pa0 = S0[0] * a2[0], py0 = S0[0] * r2[0], pa1 = S1[0] * a2[0], py1 = S1[0] * r2[0];
#pragma unroll
        for (int u = 1; u < 4; ++u) { pa0 += S0[u] * a2[u]; py0 += S0[u] * r2[u]; pa1 += S1[u] * a2[u]; py1 += S1[u] * r2[u]; }
        const float psa0 = reduce8(pa0.x + pa0.y), pyy0 = reduce8(py0.x + py0.y);
        const float psa1 = reduce8(pa1.x + pa1.y), pyy1 = reduce8(py1.x + py1.y);
        const float y0 = pyy0 + psa0 * sc.x + vv.x * sc.y, y1 = pyy1 + psa1 * sc.x + vv.y * sc.y;
        const v2f ps0 = (v2f){psa0, psa0}, ps1 = (v2f){psa1, psa1}, vv0 = (v2f){vv.x, vv.x}, vv1 = (v2f){vv.y, vv.y};
#pragma unroll
        for (int u = 0; u < 4; ++u) {
          S0[u] = S0[u] * w2[u] + ps0 * b2[u] + vv0 * k2[u];
          S1[u] = S1[u] * w2[u] + ps1 * b2[u] + vv1 * k2[u];
        }
        if (l8 == 0) *(float2*)(sY + ts * 64 + rowi) = make_float2(y0, y1);
      }
    }
    __syncthreads();
    {
      float4 o0 = *(const float4*)(sY + t * 64 + j8 * 8), o1 = *(const float4*)(sY + t * 64 + j8 * 8 + 4);
      uint4 u; u.x = pack2(o0.x, o0.y); u.y = pack2(o0.z, o0.w); u.z = pack2(o1.x, o1.y); u.w = pack2(o1.z, o1.w);
      *(uint4*)(od + row * DM + 512 + h * 64 + j8 * 8) = u;
    }
  }
  __syncthreads();
}

__device__ __forceinline__ void chunk_map32(int ci, int dir, int b, int& t0, int& L, int& rowbase) {
  const bool isctx = ci < 8;
  const int cc = isctx ? ci : ci - 8;
  const int nch = isctx ? 8 : 128;
  const int cn = dir ? nch - 1 - cc : cc;
  t0 = cn * 32;
  L = isctx ? 256 : 4096;
  rowbase = isctx ? MLAT + b * 256 : b * 4096;
}

__device__ __forceinline__ void gdn_item2(const Params& P, int item, int j) {
  extern __shared__ __attribute__((aligned(16))) char smem[];
  float* sCW = (float*)smem;
  float* sBuf = sCW + 1600;
  float* sOb = sBuf + 2 * 10368;
  const int tid = TID(), lane = tid & 63, wid = tid >> 6;
  const int half = item & 1, chain = item >> 1, dir = chain & 1, hb = chain >> 1;
  const int h = hb & 3, b = hb >> 2;
  const int qc = h * 128, kc = 512 + h * 128, vc = 1024 + h * 128 + half * 64, ocol = h * 128 + half * 64;
  const u16* p = (const u16*)(wsp(P) + OFF_R);
  u16* od = (u16*)(wsp(P) + OFF_OUTDIR) + (size_t)dir * MROWS * DM;
  const float c_a = -expf(inp(P, I_ALOG)[(j * 2 + dir) * 4 + h]);
  const float c_b = inp(P, I_DTB)[(j * 2 + dir) * 4 + h];
  {
    const float* cw = inp(P, I_CONVW) + (size_t)j * 5 * 1536;
    for (int i = tid; i < 1600; i += NT) {
      float v;
      if (i < 640) { int tap = i >> 7, c = i & 127; v = cw[tap * 1536 + h * 128 + c]; }
      else if (i < 1280) { int q = i - 640; int tap = q >> 7, c = q & 127; v = cw[tap * 1536 + 512 + h * 128 + c]; }
      else { int q = i - 1280; int tap = q >> 6, c = q & 63; v = cw[tap * 1536 + 1024 + h * 128 + half * 64 + c]; }
      sCW[i] = v;
    }
  }
  __syncthreads();
  const bool consumer = wid < 4;
  const int tp_c = (tid - 256) >> 3, part_c = tid & 7;
  auto prep = [&](int ci) {
    float* bufp = sBuf + (ci & 1) * 10368;
    float* sSc = bufp; float* sV = bufp + 128; float* sK = sV + 2048; float* sQ = sK + 4096;
    int t0, L, rowbase;
    chunk_map32(ci, dir, b, t0, L, rowbase);
    int t = tp_c, part = part_c;
    asm volatile("" : "+v"(t), "+v"(part));
    const int tt = t0 + t;
    const u16* prc = p + ((size_t)rowbase + tt) * CD_NP;
    const float ain = bf2f(prc[2048 + dir * 4 + h]), bin = bf2f(prc[2056 + dir * 4 + h]);
    float q[16], k[16], v[8];
#pragma unroll
    for (int i = 0; i < 16; ++i) { q[i] = 0.f; k[i] = 0.f; }
#pragma unroll
    for (int i = 0; i < 8; ++i) v[i] = 0.f;
    {
      uint4 r0[5], r1[5];
#pragma unroll
      for (int tap = 0; tap < 5; ++tap) {
        const int ts = tt + tap - 2;
        const bool ok = ts >= 0 && ts < L;
        const u16* pr = p + ((size_t)rowbase + (ok ? ts : tt)) * CD_NP;
        r0[tap] = ldz4(pr + qc + part * 16, ok);
        r1[tap] = ldz4(pr + qc + part * 16 + 8, ok);
      }
#pragma unroll
      for (int tap = 0; tap < 5; ++tap) {
        float x[16];
        unpack8(r0[tap], x); unpack8(r1[tap], x + 8);
#pragma unroll
        for (int i = 0; i < 16; ++i) q[i] += x[i] * sCW[tap * 128 + part * 16 + i];
      }
    }
    asm volatile("" ::: "memory");
    {
      uint4 r0[5], r1[5];
#pragma unroll
      for (int tap = 0; tap < 5; ++tap) {
        const int ts = tt + tap - 2;
        const bool ok = ts >= 0 && ts < L;
        const u16* pr = p + ((size_t)rowbase + (ok ? ts : tt)) * CD_NP;
        r0[tap] = ldz4(pr + kc + part * 16, ok);
        r1[tap] = ldz4(pr + kc + part * 16 + 8, ok);
      }
#pragma unroll
      for (int tap = 0; tap < 5; ++tap) {
        float x[16];
        unpack8(r0[tap], x); unpack8(r1[tap], x + 8);
#pragma unroll
        for (int i = 0; i < 16; ++i) k[i] += x[i] * sCW[640 + tap * 128 + part * 16 + i];
      }
    }
    asm volatile("" ::: "memory");
    {
      uint4 r0[5];
#pragma unroll
      for (int tap = 0; tap < 5; ++tap) {
        const int ts = tt + tap - 2;
        const bool ok = ts >= 0 && ts < L;
        const u16* pr = p + ((size_t)rowbase + (ok ? ts : tt)) * CD_NP;
        r0[tap] = ldz4(pr + vc + part * 8, ok);
      }
#pragma unroll
      for (int tap = 0; tap < 5; ++tap) {
        float x[8];
        unpack8(r0[tap], x);
#pragma unroll
        for (int i = 0; i < 8; ++i) v[i] += x[i] * sCW[1280 + tap * 64 + part * 8 + i];
      }
    }
    float sq = 0.f, sk = 0.f;
#pragma unroll
    for (int i = 0; i < 16; ++i) { q[i] = siluf_(q[i]); k[i] = siluf_(k[i]); sq += q[i] * q[i]; sk += k[i] * k[i]; }
    sq = reduce8(sq); sk = reduce8(sk);
    const float rq = rsqrtf(sq + 1e-6f) * 0.08838834764831845f, rk = rsqrtf(sk + 1e-6f);
    float qk = 0.f;
#pragma unroll
    for (int i = 0; i < 16; ++i) { q[i] *= rq; k[i] *= rk; qk += q[i] * k[i]; }
    qk = reduce8(qk);
#pragma unroll
    for (int i = 0; i < 16; i += 4) {
      *(float4*)(sQ + t * 128 + part * 16 + i) = make_float4(q[i], q[i + 1], q[i + 2], q[i + 3]);
      *(float4*)(sK + t * 128 + part * 16 + i) = make_float4(k[i], k[i + 1], k[i + 2], k[i + 3]);
    }
    *(float4*)(sV + t * 64 + part * 8) = make_float4(siluf_(v[0]), siluf_(v[1]), siluf_(v[2]), siluf_(v[3]));
    *(float4*)(sV + t * 64 + part * 8 + 4) = make_float4(siluf_(v[4]), siluf_(v[5]), siluf_(v[6]), siluf_(v[7]));
    if (part == 0) *(float4*)(sSc + t * 4) = make_float4(__expf(c_a * softplusf_(ain + c_b)), sigmoidf_(bin), qk, 0.f);
  };
  auto flush = [&](int ci) {
    const float* sO = sOb + (ci & 1) * 2048;
    int t0, L, rowbase;
    chunk_map32(ci, dir, b, t0, L, rowbase);
    int t = tp_c, part = part_c;
    asm volatile("" : "+v"(t), "+v"(part));
    float4 o0 = *(const float4*)(sO + t * 64 + part * 8), o1 = *(const float4*)(sO + t * 64 + part * 8 + 4);
    uint4 u; u.x = pack2(o0.x, o0.y); u.y = pack2(o0.z, o0.w); u.z = pack2(o1.x, o1.y); u.w = pack2(o1.z, o1.w);
    *(uint4*)(od + ((size_t)rowbase + t0 + t) * DM + ocol + part * 8) = u;
  };
  v2f S0[8], S1[8];
#pragma unroll
  for (int i = 0; i < 8; ++i) { S0[i] = (v2f){0.f, 0.f}; S1[i] = (v2f){0.f, 0.f}; }
  const int l8 = lane & 7, col = (wid & 3) * 16 + (lane >> 3) * 2;
  if (!consumer) prep(0);
  __syncthreads();
  for (int ci = 0; ci < 136; ++ci) {
    if (consumer) {
      const float* bufp = sBuf + (ci & 1) * 10368;
      const float* sSc = bufp; const float* sV = bufp + 128; const float* sK = sV + 2048; const float* sQ = sK + 4096;
      float* sO = sOb + (ci & 1) * 2048;
#pragma unroll 2
      for (int i = 0; i < 32; ++i) {
        const int ts = dir ? 31 - i : i;
        v2f kk[8], qq[8];
#pragma unroll
        for (int u = 0; u < 4; ++u) {
          float4 kx = *(const float4*)(sK + ts * 128 + u * 32 + l8 * 4);
          float4 qx = *(const float4*)(sQ + ts * 128 + u * 32 + l8 * 4);
          kk[2 * u] = (v2f){kx.x, kx.y}; kk[2 * u + 1] = (v2f){kx.z, kx.w};
          qq[2 * u] = (v2f){qx.x, qx.y}; qq[2 * u + 1] = (v2f){qx.z, qx.w};
        }
        const float4 sc = *(const float4*)(sSc + ts * 4);
        const float2 vv = *(const float2*)(sV + ts * 64 + col);
        const float a = sc.x, qk = sc.z;
        v2f aq0 = qq[0] * S0[0], aq1 = qq[0] * S1[0], ak0 = kk[0] * S0[0], ak1 = kk[0] * S1[0];
#pragma unroll
        for (int u = 1; u < 8; ++u) { aq0 += qq[u] * S0[u]; aq1 += qq[u] * S1[u]; ak0 += kk[u] * S0[u]; ak1 += kk[u] * S1[u]; }
        const float pq0 = reduce8(aq0.x + aq0.y), pq1 = reduce8(aq1.x + aq1.y);
        const float pk0 = reduce8(ak0.x + ak0.y), pk1 = reduce8(ak1.x + ak1.y);
        const float vn0 = sc.y * (vv.x - a * pk0), vn1 = sc.y * (vv.y - a * pk1);
        const float o0 = a * pq0 + qk * vn0, o1 = a * pq1 + qk * vn1;
        const v2f a2 = (v2f){a, a}, v20 = (v2f){vn0, vn0}, v21 = (v2f){vn1, vn1};
#pragma unroll
        for (int u = 0; u < 8; ++u) { S0[u] = a2 * S0[u] + kk[u] * v20; S1[u] = a2 * S1[u] + kk[u] * v21; }
        if (l8 == 0) *(float2*)(sO + ts * 64 + col) = make_float2(o0, o1);
      }
    } else {
      if (ci > 0) flush(ci - 1);
      if (ci + 1 < 136) prep(ci + 1);
    }
    __syncthreads();
  }
  if (!consumer) flush(135);
  __syncthreads();
}

__device__ __forceinline__ void rwkv_item2(const Params& P, int item, int j) {
  extern __shared__ __attribute__((aligned(16))) char smem[];
  float* sWup = (float*)smem;
  float* sAup = sWup + 2048;
  float* sLin = sAup + 2048;
  float* sBuf = sLin + 2048;
  float* sYb = sBuf + 2 * 12416;
  const int tid = TID(), lane = tid & 63, wid = tid >> 6;
  const int chain = item, dir = chain & 1, hb = chain >> 1, h = hb & 7, b = hb >> 3;
  const u16* p = (const u16*)(wsp(P) + OFF_R);
  u16* od = (u16*)(wsp(P) + OFF_OUTDIR) + (size_t)dir * MROWS * DM;
  float* bonus = (float*)(wsp(P) + OFF_BONUS) + (size_t)dir * MROWS * 8;
  const float* mu = inp(P, I_MU) + (size_t)j * 1760;
  {
    const float* wup = inp(P, I_WUP) + (size_t)(j * 2 + dir) * 32 * 512;
    const float* aup = inp(P, I_AUP) + (size_t)(j * 2 + dir) * 32 * 512;
    for (int i = tid; i < 2048; i += NT) {
      int l = i >> 6, c = i & 63;
      sWup[i] = wup[l * 512 + h * 64 + c];
      sAup[i] = aup[l * 512 + h * 64 + c];
    }
  }
  __syncthreads();
  constexpr int RB = 2064;
  const bool consumer = wid < 4;
  const int tp_c = (tid - 256) >> 3, j8_c = tid & 7;
  auto prep = [&](int ci) {
    float* bufp = sBuf + (ci & 1) * 12416;
    float* sSc = bufp; float* sV = bufp + 128; float* sAv = sV + 2048; float* sRW = sAv + 2048;
    float* sW = sRW + 2048; float* sBv = sW + 2048; float* sKD = sBv + 2048;
    int t0, L, rowbase;
    chunk_map32(ci, dir, b, t0, L, rowbase);
    int t = tp_c, j8 = j8_c;
    asm volatile("" : "+v"(t), "+v"(j8));
    const int hc = h * 64 + j8 * 8;
    const int cw = 1536 + dir * 32 + j8 * 4, ca = 1600 + dir * 32 + j8 * 4;
    const int tt = t0 + t;
    const size_t row = (size_t)rowbase + tt;
    uint4 pr_[3], pk_[3], pv_[3];
    uint2 pw_[3], pa_[3];
#pragma unroll
    for (int d = 0; d < 3; ++d) {
      const int ts = tt + d - 1;
      const bool ok = ts >= 0 && ts < L;
      const u16* pc = p + ((size_t)rowbase + (ok ? ts : tt)) * CD_NP + RB;
      pr_[d] = ldz4(pc + hc, ok);
      pk_[d] = ldz4(pc + 512 + hc, ok);
      pv_[d] = ldz4(pc + 1024 + hc, ok);
      pw_[d] = ldz2(pc + cw, ok);
      pa_[d] = ldz2(pc + ca, ok);
    }
    {
      float c[4], m[4], n[4];
      c[0] = lo16(pw_[1].x); c[1] = hi16(pw_[1].x); c[2] = lo16(pw_[1].y); c[3] = hi16(pw_[1].y);
      m[0] = lo16(pw_[0].x); m[1] = hi16(pw_[0].x); m[2] = lo16(pw_[0].y); m[3] = hi16(pw_[0].y);
      n[0] = lo16(pw_[2].x); n[1] = hi16(pw_[2].x); n[2] = lo16(pw_[2].y); n[3] = hi16(pw_[2].y);
#pragma unroll
      for (int i = 0; i < 4; ++i) sLin[t * 64 + j8 * 4 + i] = tanhf(c[i] + mu[cw + i] * (0.5f * (m[i] + n[i]) - c[i]));
      c[0] = lo16(pa_[1].x); c[1] = hi16(pa_[1].x); c[2] = lo16(pa_[1].y); c[3] = hi16(pa_[1].y);
      m[0] = lo16(pa_[0].x); m[1] = hi16(pa_[0].x); m[2] = lo16(pa_[0].y); m[3] = hi16(pa_[0].y);
      n[0] = lo16(pa_[2].x); n[1] = hi16(pa_[2].x); n[2] = lo16(pa_[2].y); n[3] = hi16(pa_[2].y);
#pragma unroll
      for (int i = 0; i < 4; ++i) sLin[t * 64 + 32 + j8 * 4 + i] = c[i] + mu[ca + i] * (0.5f * (m[i] + n[i]) - c[i]);
    }
    float r[8], k[8], v[8];
    shiftmix8(pr_[1], pr_[0], pr_[2], mu + hc, r);
    shiftmix8(pk_[1], pk_[0], pk_[2], mu + 512 + hc, k);
    shiftmix8(pv_[1], pv_[0], pv_[2], mu + 1024 + hc, v);
    __builtin_amdgcn_fence(__ATOMIC_RELEASE, "wavefront");
    __builtin_amdgcn_wave_barrier();
    __builtin_amdgcn_fence(__ATOMIC_ACQUIRE, "wavefront");
    float lw[8], la[8];
    {
      const float* w0 = inp(P, I_W0) + (size_t)(j * 2 + dir) * 512 + hc;
      const float* a0 = inp(P, I_A0) + (size_t)(j * 2 + dir) * 512 + hc;
#pragma unroll
      for (int i = 0; i < 8; ++i) { lw[i] = w0[i]; la[i] = a0[i]; }
    }
#pragma unroll 4
    for (int l = 0; l < 32; ++l) {
      float x = sLin[t * 64 + l], y = sLin[t * 64 + 32 + l];
      float4 wa = *(const float4*)(sWup + l * 64 + j8 * 8), wb = *(const float4*)(sWup + l * 64 + j8 * 8 + 4);
      float4 aa = *(const float4*)(sAup + l * 64 + j8 * 8), ab = *(const float4*)(sAup + l * 64 + j8 * 8 + 4);
      lw[0] += x * wa.x; lw[1] += x * wa.y; lw[2] += x * wa.z; lw[3] += x * wa.w;
      lw[4] += x * wb.x; lw[5] += x * wb.y; lw[6] += x * wb.z; lw[7] += x * wb.w;
      la[0] += y * aa.x; la[1] += y * aa.y; la[2] += y * aa.z; la[3] += y * aa.w;
      la[4] += y * ab.x; la[5] += y * ab.y; la[6] += y * ab.z; la[7] += y * ab.w;
    }
    const float* kkp = inp(P, I_KK) + (size_t)j * 512 + hc;
    const float* kap = inp(P, I_KA) + (size_t)j * 512 + hc;
    const float* rkp = inp(P, I_RK) + (size_t)(j * 8 + h) * 64 + j8 * 8;
    float kx[8], ss = 0.f;
#pragma unroll
    for (int i = 0; i < 8; ++i) { kx[i] = k[i] * kkp[i]; ss += kx[i] * kx[i]; }
    ss = reduce8(ss);
    const float rn = rsqrtf(ss + 1e-6f);
    float av[8], rw[8], wv[8], bv[8], kd[8];
    float rb = 0.f, rk = 0.f, bon = 0.f;
    float one = 1.0f;
    asm volatile("" : "+v"(one));
#pragma unroll
    for (int i = 0; i < 8; ++i) {
      float w = __expf(-0.6065306597126334f * __builtin_amdgcn_rcpf(one + __expf(-lw[i])));
      float aa = __builtin_amdgcn_rcpf(one + __expf(-la[i]));
      float kk = kx[i] * rn;
      kd[i] = k[i] * (one + (aa - one) * kap[i]);
      av[i] = -kk; bv[i] = kk * aa; rw[i] = r[i] * w; wv[i] = w;
      rb += r[i] * bv[i]; rk += r[i] * kd[i]; bon += r[i] * kd[i] * rkp[i];
    }
    rb = reduce8(rb); rk = reduce8(rk); bon = reduce8(bon);
    const int o = t * 64 + j8 * 8;
    *(float4*)(sAv + o) = make_float4(av[0], av[1], av[2], av[3]); *(float4*)(sAv + o + 4) = make_float4(av[4], av[5], av[6], av[7]);
    *(float4*)(sRW + o) = make_float4(rw[0], rw[1], rw[2], rw[3]); *(float4*)(sRW + o + 4) = make_float4(rw[4], rw[5], rw[6], rw[7]);
    *(float4*)(sW + o) = make_float4(wv[0], wv[1], wv[2], wv[3]); *(float4*)(sW + o + 4) = make_float4(wv[4], wv[5], wv[6], wv[7]);
    *(float4*)(sBv + o) = make_float4(bv[0], bv[1], bv[2], bv[3]); *(float4*)(sBv + o + 4) = make_float4(bv[4], bv[5], bv[6], bv[7]);
    *(float4*)(sKD + o) = make_float4(kd[0], kd[1], kd[2], kd[3]); *(float4*)(sKD + o + 4) = make_float4(kd[4], kd[5], kd[6], kd[7]);
    *(float4*)(sV + o) = make_float4(v[0], v[1], v[2], v[3]); *(float4*)(sV + o + 4) = make_float4(v[4], v[5], v[6], v[7]);
    if (j8 == 0) {
      *(float2*)(sSc + t * 4) = make_float2(rb, rk);
      bonus[row * 8 + h] = bon;
    }
  };
  auto flush = [&](int ci) {
    const float* sY = sYb + (ci & 1) * 2048;
    int t0, L, rowbase;
    chunk_map32(ci, dir, b, t0, L, rowbase);
    int t = tp_c, j8 = j8_c;
    asm volatile("" : "+v"(t), "+v"(j8));
    float4 o0 = *(const float4*)(sY + t * 64 + j8 * 8), o1 = *(const float4*)(sY + t * 64 + j8 * 8 + 4);
    uint4 u; u.x = pack2(o0.x, o0.y); u.y = pack2(o0.z, o0.w); u.z = pack2(o1.x, o1.y); u.w = pack2(o1.z, o1.w);
    *(uint4*)(od + ((size_t)rowbase + t0 + t) * DM + 512 + h * 64 + j8 * 8) = u;
  };
  v2f S0[4], S1[4];
#pragma unroll
  for (int i = 0; i < 4; ++i) { S0[i] = (v2f){0.f, 0.f}; S1[i] = (v2f){0.f, 0.f}; }
  const int l8 = lane & 7, rowi = (wid & 3) * 16 + (lane >> 3) * 2;
  if (!consumer) prep(0);
  __syncthreads();
  for (int ci = 0; ci < 136; ++ci) {
    if (consumer) {
      const float* bufp = sBuf + (ci & 1) * 12416;
      const float* sSc = bufp; const float* sV = bufp + 128; const float* sAv = sV + 2048; const float* sRW = sAv + 2048;
      const float* sW = sRW + 2048; const float* sBv = sW + 2048; const float* sKD = sBv + 2048;
      float* sY = sYb + (ci & 1) * 2048;
#pragma unroll 2
      for (int i = 0; i < 32; ++i) {
        const int ts = dir ? 31 - i : i;
        v2f a2[4], r2[4], w2[4], b2[4], k2[4];
#pragma unroll
        for (int u = 0; u < 2; ++u) {
          const int o = ts * 64 + u * 32 + l8 * 4;
          float4 x;
          x = *(const float4*)(sAv + o); a2[2 * u] = (v2f){x.x, x.y}; a2[2 * u + 1] = (v2f){x.z, x.w};
          x = *(const float4*)(sRW + o); r2[2 * u] = (v2f){x.x, x.y}; r2[2 * u + 1] = (v2f){x.z, x.w};
          x = *(const float4*)(sW + o); w2[2 * u] = (v2f){x.x, x.y}; w2[2 * u + 1] = (v2f){x.z, x.w};
          x = *(const float4*)(sBv + o); b2[2 * u] = (v2f){x.x, x.y}; b2[2 * u + 1] = (v2f){x.z, x.w};
          x = *(const float4*)(sKD + o); k2[2 * u] = (v2f){x.x, x.y}; k2[2 * u + 1] = (v2f){x.z, x.w};
        }
        const float2 sc = *(const float2*)(sSc + ts * 4);
        const float2 vv = *(const float2*)(sV + ts * 64 + rowi);
        v2f pa0 = S0[0] * a2[0], py0 = S0[0] * r2[0], pa1 = S1[0] * a2[0], py1 = S1[0] * r2[0];
#pragma unroll
        for (int u = 1; u < 4; ++u) { pa0 += S0[u] * a2[u]; py0 += S0[u] * r2[u]; pa1 += S1[u] * a2[u]; py1 += S1[u] * r2[u]; }
        const float psa0 = reduce8(pa0.x + pa0.y), pyy0 = reduce8(py0.x + py0.y);
        const float psa1 = reduce8(pa1.x + pa1.y), pyy1 = reduce8(py1.x + py1.y);
        const float y0 = pyy0 + psa0 * sc.x + vv.x * sc.y, y1 = pyy1 + psa1 * sc.x + vv.y * sc.y;
        const v2f ps0 = (v2f){psa0, psa0}, ps1 = (v2f){psa1, psa1}, vv0 = (v2f){vv.x, vv.x}, vv1 = (v2f){vv.y, vv.y};
#pragma unroll
        for (int u = 0; u < 4; ++u) {
          S0[u] = S0[u] * w2[u] + ps0 * b2[u] + vv0 * k2[u];
          S1[u] = S1[u] * w2[u] + ps1 * b2[u] + vv1 * k2[u];
        }
        if (l8 == 0) *(float2*)(sY + ts * 64 + rowi) = make_float2(y0, y1);
      }
    } else {
      if (ci > 0) flush(ci - 1);
      if (ci + 1 < 136) prep(ci + 1);
    }
    __syncthreads();
  }
  if (!consumer) flush(135);
  __syncthreads();
}

__device__ __forceinline__ void s5_item(const Params& P, int item, int j) {
  extern __shared__ __attribute__((aligned(16))) char smem[];
  u16* sGuB = (u16*)smem;
  u16* sBB = sGuB + 1024;
  u16* sCC = sBB + 2048;
  u16* sHb = sCC + 16 * 136;
  float* sH = (float*)(sHb + 64 * 136);
  const int tid = TID(), lane = tid & 63, wid = tid >> 6, fr = lane & 15, fq = lane >> 4;
  const int dir = item & 1, bg = item >> 1, g = bg & 15, b = bg >> 4;
  const float* tab = (const float*)(wsp(P) + OFF_S5TAB) + (size_t)(j * 2 + dir) * 34816;
  const u16* p = (const u16*)(wsp(P) + OFF_R);
  u16* od = (u16*)(wsp(P) + OFF_OUTDIR) + (size_t)dir * MROWS * DM;
  for (int i = tid; i < 2048; i += NT) {
    const int pp = i >> 4, c = i & 15;
    const float v = pp < 64 ? tab[2048 + (g * 64 + pp) * 16 + c] : tab[2048 + 16384 + (g * 64 + pp - 64) * 16 + c];
    sBB[i] = f2bf(v);
    const int cc = i >> 7, k = i & 127;
    const float w = k < 64 ? inp(P, I_CRE)[((size_t)(j * 16 + g) * 16 + cc) * 64 + k]
                           : -inp(P, I_CIM)[((size_t)(j * 16 + g) * 16 + cc) * 64 + (k - 64)];
    sCC[cc * 136 + k] = f2bf(w);
  }
  float lbr = 0.f, lbi = 0.f, hr = 0.f, hi = 0.f;
  if (tid < 64) { lbr = tab[g * 64 + tid]; lbi = tab[1024 + g * 64 + tid]; }
  const int idx_c = tid * 2;
  unsigned gu_pf;
  {
    int t0n, Ln, rowbasen; bool isctxn;
    chunk_map(0, dir, b, t0n, Ln, rowbasen, isctxn);
    gu_pf = *(const unsigned*)(p + ((size_t)rowbasen + t0n + (idx_c >> 4)) * AB_NP + g * 16 + (idx_c & 15));
  }
  __syncthreads();
  for (int ci = 0; ci < 68; ++ci) {
    int t0, L, rowbase; bool isctx;
    chunk_map(ci, dir, b, t0, L, rowbase, isctx);
    {
      const int tl = idx_c >> 4, c = idx_c & 15, ip = dir ? 63 - tl : tl;
      *(unsigned*)(sGuB + ip * 16 + c) = gu_pf;
    }
    __syncthreads();
    if (ci + 1 < 68) {
      int t0n, Ln, rowbasen; bool isctxn;
      chunk_map(ci + 1, dir, b, t0n, Ln, rowbasen, isctxn);
      gu_pf = *(const unsigned*)(p + ((size_t)rowbasen + t0n + (idx_c >> 4)) * AB_NP + g * 16 + (idx_c & 15));
    }
    {
      const uint4 z = make_uint4(0u, 0u, 0u, 0u);
      uint4 bu4 = *(const uint4*)(sBB + (wid * 16 + fr) * 16 + (fq & 1) * 8);
      if (fq >= 2) bu4 = z;
      const bf16x8 bop = __builtin_bit_cast(bf16x8, bu4);
#pragma unroll
      for (int m = 0; m < 4; ++m) {
        uint4 a4 = *(const uint4*)(sGuB + (m * 16 + fr) * 16 + (fq & 1) * 8);
        if (fq >= 2) a4 = z;
        f32x4 acc = (f32x4){0.f, 0.f, 0.f, 0.f};
        acc = __builtin_amdgcn_mfma_f32_16x16x32_bf16(__builtin_bit_cast(bf16x8, a4), bop, acc, 0, 0, 0);
#pragma unroll
        for (int rr = 0; rr < 4; ++rr) sH[(m * 16 + fq * 4 + rr) * 132 + wid * 16 + fr] = acc[rr];
      }
    }
    __syncthreads();
    if (tid < 64) {
#pragma unroll 1
      for (int b0 = 0; b0 < 64; b0 += 16) {
        float br[16], bi[16];
#pragma unroll
        for (int i = 0; i < 16; ++i) { br[i] = sH[(b0 + i) * 132 + tid]; bi[i] = sH[(b0 + i) * 132 + 64 + tid]; }
#pragma unroll
        for (int i = 0; i < 16; ++i) {
          float nr = lbr * hr - lbi * hi + br[i];
          float ni = lbr * hi + lbi * hr + bi[i];
          hr = nr; hi = ni;
          sHb[(b0 + i) * 136 + tid] = f2bf(hr);
          sHb[(b0 + i) * 136 + 64 + tid] = f2bf(hi);
        }
      }
    }
    __syncthreads();
    if (wid < 4) {
      f32x4 acc = (f32x4){0.f, 0.f, 0.f, 0.f};
#pragma unroll
      for (int kb = 0; kb < 4; ++kb) {
        bf16x8 a = *reinterpret_cast<const bf16x8*>(sHb + (wid * 16 + fr) * 136 + kb * 32 + fq * 8);
        bf16x8 bb = *reinterpret_cast<const bf16x8*>(sCC + fr * 136 + kb * 32 + fq * 8);
        acc = __builtin_amdgcn_mfma_f32_16x16x32_bf16(a, bb, acc, 0, 0, 0);
      }
#pragma unroll
      for (int rr = 0; rr < 4; ++rr) {
        const int i = wid * 16 + fq * 4 + rr, tok = dir ? 63 - i : i;
        od[((size_t)rowbase + t0 + tok) * DM + g * 16 + fr] = f2bf(acc[rr]);
      }
    }
  }
  __syncthreads();
}

__device__ __forceinline__ void scan_ab(const Params& P, int j) {
  const int nb = gridDim.x, bi = BID();
  const bool split = nb == 256;
  for (int it = bi; it < 96; it += nb) ret_item(P, it, j);
  const int s0 = split ? bi - 96 : bi, sstep = split ? 160 : nb;
  if (s0 >= 0)
    for (int it = s0; it < 256; it += sstep) s5_item(P, it, j);
}
__device__ __forceinline__ void scan_cd(const Params& P, int j) {
  for (int it = BID(); it < 128; it += gridDim.x) gdn_item2(P, it, j);
  for (int it = BID(); it < 256; it += gridDim.x)
    if (it >= 128) rwkv_item2(P, it - 128, j);
}

__device__ __forceinline__ void finish_ab(const Params& P, int j) {
  const int tid_ = TID(); const int lane = tid_ & 63, wave = tid_ >> 6;
  const u16* p = (const u16*)(wsp(P) + OFF_R);
  const u16* od0 = (const u16*)(wsp(P) + OFF_OUTDIR);
  const u16* od1 = od0 + (size_t)MROWS * DM;
  u16* mix = (u16*)(wsp(P) + OFF_XMOD);
  u16* zbuf = (u16*)(wsp(P) + OFF_ZBUF);
  const float* dsk = inp(P, I_S5D) + j * 256;
  const int stride = gridDim.x * 8;
  unsigned u0[8], u1[8], ux[8], n0[8], n1[8], nx[8];
  auto loadrow = [&](int row, unsigned* a0, unsigned* a1, unsigned* ax) {
    const u16* pr = p + (size_t)row * AB_NP;
#pragma unroll
    for (int seg = 0; seg < 8; ++seg) {
      const int c = seg * 128 + lane * 2;
      a0[seg] = *(const unsigned*)(od0 + (size_t)row * DM + c);
      a1[seg] = *(const unsigned*)(od1 + (size_t)row * DM + c);
      ax[seg] = *(const unsigned*)(pr + (seg < 2 ? c : c + 2304));
    }
  };
  int row = BID() * 8 + wave;
  if (row < MROWS) loadrow(row, u0, u1, ux);
  while (row < MROWS) {
    const int nrow = row + stride;
    if (nrow < MROWS) loadrow(nrow, n0, n1, nx);
#pragma unroll
    for (int seg = 0; seg < 8; ++seg) {
      const int c = seg * 128 + lane * 2;
      float a0 = lo16(u0[seg]) + lo16(u1[seg]), a1 = hi16(u0[seg]) + hi16(u1[seg]);
      if (seg < 2) {
        float y0 = a0 + dsk[c] * lo16(ux[seg]), y1 = a1 + dsk[c + 1] * hi16(ux[seg]);
        *(unsigned*)(zbuf + (size_t)row * 256 + c) = pack2(geluf_(y0), geluf_(y1));
      } else {
        float mu = wave_sum(a0 + a1) * (1.0f / 128.0f);
        float d0 = a0 - mu, d1 = a1 - mu;
        float var = wave_sum(d0 * d0 + d1 * d1) * (1.0f / 128.0f);
        float rs = rsqrtf(var + 1e-5f);
        *(unsigned*)(mix + (size_t)row * DM + c) = pack2(siluf_(lo16(ux[seg])) * d0 * rs, siluf_(hi16(ux[seg])) * d1 * rs);
      }
    }
#pragma unroll
    for (int seg = 0; seg < 8; ++seg) { u0[seg] = n0[seg]; u1[seg] = n1[seg]; ux[seg] = nx[seg]; }
    row = nrow;
  }
}

struct RowCD {
  unsigned u0[4], u1[4], uz[4];
  uint4 y0, y1, vc, vm, vn;
  unsigned gc, gm, gn, hc, hm, hn;
  float b0, b1;
};
__device__ __forceinline__ void finish_cd(const Params& P, int j) {
  extern __shared__ __attribute__((aligned(16))) char smem[];
  u16* sG = (u16*)smem;
  const int tid = TID(), lane = tid & 63, wave = tid >> 6;
  {
    const float* gup = inp(P, I_GUP) + (size_t)j * 96 * 512;
    for (int i = tid * 2; i < 96 * 512; i += NT * 2) *(unsigned*)(sG + i) = pack2(gup[i], gup[i + 1]);
  }
  __syncthreads();
  const u16* p = (const u16*)(wsp(P) + OFF_R);
  const u16* od0 = (const u16*)(wsp(P) + OFF_OUTDIR);
  const u16* od1 = od0 + (size_t)MROWS * DM;
  const float* bon0 = (const float*)(wsp(P) + OFF_BONUS);
  const float* bon1 = bon0 + (size_t)MROWS * 8;
  u16* mix = (u16*)(wsp(P) + OFF_XMOD);
  const float* mu = inp(P, I_MU) + (size_t)j * 1760;
  const float* gnw = inp(P, I_GNW) + j * 128;
  const float* lnw = inp(P, I_LNW) + j * 512;
  const float* lnb = inp(P, I_LNBB) + j * 512;
  constexpr int RB = 2064;
  const int ch = lane * 8, head = lane >> 3;
  const int stride = gridDim.x * 8;
  auto loadrow = [&](int row, RowCD& R_) {
    const u16* pr = p + (size_t)row * CD_NP;
#pragma unroll
    for (int seg = 0; seg < 4; ++seg) {
      const int c = seg * 128 + lane * 2;
      R_.u0[seg] = *(const unsigned*)(od0 + (size_t)row * DM + c);
      R_.u1[seg] = *(const unsigned*)(od1 + (size_t)row * DM + c);
      R_.uz[seg] = *(const unsigned*)(pr + 1536 + c);
    }
    int tt, L;
    if (row < MLAT) { tt = row & 4095; L = 4096; } else { tt = (row - MLAT) & 255; L = 256; }
    const bool hm_ = tt > 0, hn_ = tt < L - 1;
    const u16* pc = pr + RB;
    const u16* pm = hm_ ? pc - CD_NP : pc;
    const u16* pp = hn_ ? pc + CD_NP : pc;
    R_.y0 = *(const uint4*)(od0 + (size_t)row * DM + 512 + ch);
    R_.y1 = *(const uint4*)(od1 + (size_t)row * DM + 512 + ch);
    R_.vc = *(const uint4*)(pc + 1024 + ch);
    R_.vm = ldz4(pm + 1024 + ch, hm_);
    R_.vn = ldz4(pp + 1024 + ch, hn_);
    const int c1 = 1664 + lane, c2 = 1664 + 64 + (lane & 31);
    R_.gc = pc[c1]; R_.gm = hm_ ? (unsigned)pm[c1] : 0u; R_.gn = hn_ ? (unsigned)pp[c1] : 0u;
    R_.hc = pc[c2]; R_.hm = hm_ ? (unsigned)pm[c2] : 0u; R_.hn = hn_ ? (unsigned)pp[c2] : 0u;
    R_.b0 = bon0[(size_t)row * 8 + head]; R_.b1 = bon1[(size_t)row * 8 + head];
  };
  RowCD A_, N_;
  int row = BID() * 8 + wave;
  if (row < MROWS) loadrow(row, A_);
  while (row < MROWS) {
    const int nrow = row + stride;
    if (nrow < MROWS) loadrow(nrow, N_);
#pragma unroll
    for (int seg = 0; seg < 4; ++seg) {
      const int c = seg * 128 + lane * 2;
      float a0 = lo16(A_.u0[seg]) + lo16(A_.u1[seg]), a1 = hi16(A_.u0[seg]) + hi16(A_.u1[seg]);
      float ms = wave_sum(a0 * a0 + a1 * a1) * (1.0f / 128.0f);
      float rs = rsqrtf(ms + 1e-6f);
      *(unsigned*)(mix + (size_t)row * DM + c) =
          pack2(a0 * rs * gnw[lane * 2] * siluf_(lo16(A_.uz[seg])), a1 * rs * gnw[lane * 2 + 1] * siluf_(hi16(A_.uz[seg])));
    }
    float sg0, sg1;
    {
      float c = lo16(A_.gc), m = lo16(A_.gm), n = lo16(A_.gn);
      sg0 = sigmoidf_(c + mu[1664 + lane] * (0.5f * (m + n) - c));
      c = lo16(A_.hc); m = lo16(A_.hm); n = lo16(A_.hn);
      sg1 = sigmoidf_(c + mu[1664 + 64 + (lane & 31)] * (0.5f * (m + n) - c));
    }
    v2f g2[4];
#pragma unroll
    for (int i = 0; i < 4; ++i) g2[i] = (v2f){0.f, 0.f};
#pragma unroll 8
    for (int l = 0; l < 64; ++l) {
      const float s = __int_as_float(__builtin_amdgcn_readlane(__float_as_int(sg0), l));
      const uint4 u = *(const uint4*)(sG + l * 512 + ch);
      const v2f s2 = (v2f){s, s};
      g2[0] += s2 * (v2f){lo16(u.x), hi16(u.x)}; g2[1] += s2 * (v2f){lo16(u.y), hi16(u.y)};
      g2[2] += s2 * (v2f){lo16(u.z), hi16(u.z)}; g2[3] += s2 * (v2f){lo16(u.w), hi16(u.w)};
    }
#pragma unroll 8
    for (int l = 0; l < 32; ++l) {
      const float s = __int_as_float(__builtin_amdgcn_readlane(__float_as_int(sg1), l));
      const uint4 u = *(const uint4*)(sG + (64 + l) * 512 + ch);
      const v2f s2 = (v2f){s, s};
      g2[0] += s2 * (v2f){lo16(u.x), hi16(u.x)}; g2[1] += s2 * (v2f){lo16(u.y), hi16(u.y)};
      g2[2] += s2 * (v2f){lo16(u.z), hi16(u.z)}; g2[3] += s2 * (v2f){lo16(u.w), hi16(u.w)};
    }
    float g[8] = {g2[0].x, g2[0].y, g2[1].x, g2[1].y, g2[2].x, g2[2].y, g2[3].x, g2[3].y};
    float y[8], y1[8], v[8];
    unpack8(A_.y0, y); unpack8(A_.y1, y1);
    float s = 0.f;
#pragma unroll
    for (int i = 0; i < 8; ++i) { y[i] += y1[i]; s += y[i]; }
    float mean = reduce8(s) * (1.0f / 64.0f);
    float q = 0.f;
#pragma unroll
    for (int i = 0; i < 8; ++i) { y[i] -= mean; q += y[i] * y[i]; }
    float rs = rsqrtf(reduce8(q) * (1.0f / 64.0f) + 64e-5f);
    shiftmix8(A_.vc, A_.vm, A_.vn, mu + 1024 + ch, v);
    const float bon = A_.b0 + A_.b1;
    float o[8];
#pragma unroll
    for (int i = 0; i < 8; ++i) o[i] = (y[i] * rs * lnw[ch + i] + lnb[ch + i] + bon * v[i]) * g[i];
    uint4 u; u.x = pack2(o[0], o[1]); u.y = pack2(o[2], o[3]); u.z = pack2(o[4], o[5]); u.w = pack2(o[6], o[7]);
    *(uint4*)(mix + (size_t)row * DM + 512 + ch) = u;
    A_ = N_;
    row = nrow;
  }
}

#define XB_TMO      128
#define XB_XCNT(j)  (256  + 64 * (j))
#define XB_XSUB(j)  (1280 + 64 * (j))
#define XB_XGEN(j)  (2304 + 64 * (j))
#define XB_TOP      3328
#define XB_TOPGEN   3392
#define XCD_BAR_WORDS 3456
#define XB_SPIN_CAP (1u << 20)
#define LAS __attribute__((address_space(3)))
__device__ __forceinline__ unsigned xb_ld(unsigned* p)              { return __hip_atomic_load(p, __ATOMIC_RELAXED, __HIP_MEMORY_SCOPE_AGENT); }
__device__ __forceinline__ unsigned xb_add(unsigned* p, unsigned v) { return __hip_atomic_fetch_add(p, v, __ATOMIC_RELAXED, __HIP_MEMORY_SCOPE_AGENT); }
__device__ __forceinline__ unsigned xb_xcc_id() { return (unsigned)__builtin_amdgcn_s_getreg((3 << 11) | 20) & 0xFu; }
#define XB_SPIN(cond, bar) do { unsigned _sp = 0; while (cond) { __builtin_amdgcn_s_sleep(1); \
    if ((++_sp & 255u) == 0u) { if (xb_ld(&(bar)[XB_TMO])) break; if (_sp > XB_SPIN_CAP) { atomicAdd(&(bar)[XB_TMO], 1u); break; } } } } while (0)
struct XcdBarrier { unsigned* bar; unsigned x; volatile LAS unsigned* st; };
__device__ __forceinline__ XcdBarrier xcd_barrier_post(unsigned* bar, volatile LAS unsigned* st) {
    XcdBarrier b; b.bar = bar; b.x = xb_xcc_id(); b.st = st;
    if (threadIdx.x == 0) (void)xb_add(&bar[XB_XCNT(b.x)], 1u);
    return b;
}
__device__ __forceinline__ void xcd_barrier_complete(unsigned* bar, unsigned x, unsigned& nloc, unsigned& nx) {
    const unsigned G = gridDim.x * gridDim.y * gridDim.z;
    unsigned sum, cnt, mine, sp = 0u;
    for (;;) {
        sum = 0u; cnt = 0u; mine = 0u;
#pragma unroll
        for (unsigned j = 0; j < 16; ++j) { const unsigned c = xb_ld(&bar[XB_XCNT(j)]); sum += c; cnt += (c > 0u) ? 1u : 0u; mine = (j == x) ? c : mine; }
        if (sum == G) break;
        __builtin_amdgcn_s_sleep(1);
        if ((++sp & 255u) == 0u) { if (xb_ld(&bar[XB_TMO])) break; if (sp > XB_SPIN_CAP) { atomicAdd(&bar[XB_TMO], 1u); break; } }
    }
    nloc = mine > 0u ? mine : 1u; nx = cnt > 0u ? cnt : 1u;
}
__device__ __forceinline__ void xcd_barrier(const XcdBarrier& b) {
    asm volatile("s_waitcnt vmcnt(0)" ::: "memory");
    __syncthreads();
    if (threadIdx.x == 0) {
        unsigned* bar = b.bar;
        __builtin_amdgcn_s_waitcnt(0);
        unsigned nloc = b.st[0], nx = b.st[1];
        if (nloc == 0u) { xcd_barrier_complete(bar, b.x, nloc, nx); b.st[0] = nloc; b.st[1] = nx; }
        const unsigned old = xb_add(&bar[XB_XSUB(b.x)], 1u);
        const unsigned gen = old / nloc;
        if (old + 1u == (gen + 1u) * nloc) {
            __builtin_amdgcn_fence(__ATOMIC_RELEASE, "agent");
            asm volatile("s_waitcnt vmcnt(0)" ::: "memory");
            const unsigned og = xb_add(&bar[XB_TOP], 1u);
            const unsigned tg = og / nx;
            if (og + 1u == (tg + 1u) * nx) xb_add(&bar[XB_TOPGEN], 1u);
            else XB_SPIN(xb_ld(&bar[XB_TOPGEN]) == tg, bar);
            __builtin_amdgcn_fence(__ATOMIC_ACQUIRE, "agent");
            xb_add(&bar[XB_XGEN(b.x)], 1u);
            asm volatile("s_waitcnt vmcnt(0)" ::: "memory");
        } else {
            XB_SPIN(xb_ld(&bar[XB_XGEN(b.x)]) == gen, bar);
            __builtin_amdgcn_fence(__ATOMIC_ACQUIRE, "agent");
            asm volatile("s_waitcnt vmcnt(0)" ::: "memory");
        }
    }
    __syncthreads();
}

__global__ void __launch_bounds__(NT) mega(Params P) {
  cg::grid_group grid = cg::this_grid();
  __shared__ uint4 xb_words;
  if (threadIdx.x == 0) xb_words = make_uint4(0u, 0u, 0u, 0u);
  __syncthreads();
  const XcdBarrier xb = xcd_barrier_post((unsigned*)(P.ws + OFF_BAR), (volatile LAS unsigned*)&xb_words);
  float* mods = (float*)(wsp(P) + OFF_MODS);
  u16* xmod = (u16*)(wsp(P) + OFF_XMOD);
  u16* R = (u16*)(wsp(P) + OFF_R);
  for (int step = 0; step < 50; ++step) {
    int l = 0, kind = -1, cv = -1;
    if (step == 0) cv = 0;
    if (step >= 2) { l = (step - 2) / 12; kind = (step - 2) % 12; if (kind == 2 && l < 3) cv = l + 1; }
    const u16* wb = (const u16*)(wsp(P) + (size_t)(l & 1) * WB_SLOT);
    const float* ml = mods + (size_t)l * 9 * 9216;
    const int j = l >> 1;
    const bool ab = (l & 1) == 0;
    if (step == 0) {
      mods_phase(P);
      tables_phase(P);
    } else if (step == 1 || kind == 2 || kind == 8 || kind == 11) {
      const int sub = kind == 2 ? 0 : (kind == 8 ? 1 : 2);
      const float* lng = inp(P, I_LNG) + (size_t)(l * 3 + sub) * 1024;
      const float* lnb = inp(P, I_LNB) + (size_t)(l * 3 + sub) * 1024;
      const float* mn = step == 1 ? mods : (kind == 11 ? (l < 3 ? ml + 9 * 9216 : nullptr) : ml);
      const int js = (step == 1 || kind == 11) ? 0 : (kind == 2 ? 3 : 6);
      const bool lastpost = (l == 3) && (kind == 8 || kind == 11);
      rowpass(P, step == 1, lng, lnb, mn, js, js + 1, lastpost ? MLAT : MROWS, step != 1 && !lastpost);
    } else if (kind == 0 || kind == 9) {
      EpiArgs e{}; e.outbf = R; e.ld = DFF;
      e.nm = (l == 3 && kind == 9) ? 128 : 0;
      for (int rep = 0; rep < ((PROBE_MASK & 4) ? 2 : 1); ++rep)
        gemm_phase<EPI_ACT>(P, xmod, wb + (kind == 0 ? WFI0 : WFI1), 5632, 1024, e);
    } else if (kind == 1 || kind == 7 || kind == 10) {
      EpiArgs e{};
      e.gate = ml + (kind == 1 ? 2 : (kind == 7 ? 5 : 8)) * 1024;
      e.sc = kind == 7 ? 1.0f : 0.5f;
      const u16* A = kind == 7 ? xmod : R;
      const u16* B = wb + (kind == 1 ? WFO0 : (kind == 7 ? WMO : WFO1));
      {
        const int pl = kind == 1 ? l - 1 : l, psub = kind == 1 ? 2 : (kind == 7 ? 0 : 1);
        if (pl >= 0) { e.plng = inp(P, I_LNG) + (size_t)(pl * 3 + psub) * 1024; e.plnb = inp(P, I_LNB) + (size_t)(pl * 3 + psub) * 1024; }
        else e.hsrc = inp(P, I_X);
      }
      e.nm = 128;
      e.split = !((l == 3) && kind != 1);
      gemm_phase<EPI_RES>(P, A, B, 1024, kind == 7 ? 1024 : DFF, e);
    } else if (kind == 3) {
      EpiArgs e{}; e.outbf = R; e.ld = ab ? AB_NP : CD_NP;
      gemm_phase<EPI_PBF>(P, xmod, wb + WMI, ab ? AB_NP : CD_NP, 1024, e);
    } else if (kind == 4) {
      for (int rep = 0; rep < ((ab ? (PROBE_MASK & 1) : (PROBE_MASK & 2)) ? 2 : 1); ++rep) {
        if (ab) scan_ab(P, j); else scan_cd(P, j);
      }
    } else if (kind == 5) {
      if (ab) finish_ab(P, j); else finish_cd(P, j);
    } else if (kind == 6) {
      if (!ab) continue;
      EpiArgs e{}; e.outbf = xmod; e.ld = DM; e.zbuf = (const u16*)(wsp(P) + OFF_ZBUF); e.glub = inp(P, I_GLUB) + j * 256;
      gemm_phase<EPI_GLU>(P, (const u16*)(wsp(P) + OFF_ZBUF), wb + WGLU, 256, 256, e);
    }
    if (cv >= 0) convert_layer(P, cv);
    if (step == 0) grid.sync();
    else xcd_barrier(xb);
  }
}

extern "C" void kernel_launch(void* const* d_in, const int* in_sizes, int n_in, void* d_out,
                              int out_size, void* d_ws, size_t ws_size, hipStream_t stream) {
  static int grid_blocks = 0;
  if (!grid_blocks) {
    int dev = 0, cus = 0, per_cu = 0;
    (void)hipGetDevice(&dev);
    (void)hipDeviceGetAttribute(&cus, hipDeviceAttributeMultiprocessorCount, dev);
    (void)hipFuncSetAttribute((const void*)mega, hipFuncAttributeMaxDynamicSharedMemorySize, LDS_BYTES);
    (void)hipOccupancyMaxActiveBlocksPerMultiprocessor(&per_cu, (const void*)mega, NT, LDS_BYTES);
    if (per_cu < 1) fprintf(stderr, "occupancy query says %d blocks/CU\n", per_cu);
    grid_blocks = cus;
    if (ws_size < WS_END) fprintf(stderr, "workspace too small: %zu < %zu\n", ws_size, (size_t)WS_END);
  }
  Params p{};
  for (int i = 0; i < 40; ++i) p.in[i] = (const float*)d_in[i];
  p.out = (float*)d_out;
  p.ws = (char*)d_ws;
  void* args[] = {&p};
  (void)hipMemsetAsync((char*)d_ws + OFF_BAR, 0, 16384, stream);
  hipError_t e = hipLaunchCooperativeKernel((void*)mega, dim3(grid_blocks), dim3(NT), args, LDS_BYTES, stream);
  if (e != hipSuccess) fprintf(stderr, "cooperative launch failed: %s (grid %d)\n", hipGetErrorString(e), grid_blocks);
}
```
